# Optimizing an MI355X kernel written in HIP

```python
import math
import jax, jax.numpy as jnp
from jax import lax
import numpy as np

D_MODEL = 2048
BATCH = 2
SEQ = 8192
DEPTH = 1

D_RNN = D_MODEL
RG_HEADS = 16
RG_HEAD_DIM = D_RNN // RG_HEADS
CONV_WIDTH = 4
RG_C = 8.0
D_SSM = D_MODEL // 2
SSM_GROUP = 16
SSM_GROUPS = D_SSM // SSM_GROUP
SSM_STATE = 64
D_FF = 4 * D_MODEL
D_IN = 2 * D_RNN + D_SSM + 2 * D_MODEL
LN_EPS = 1e-5

kernel_name = "hybrid_rglru_s5_gated_deepnorm_block"


def _layernorm(x, g, b):
    xf = x.astype(jnp.float32)
    mu = jnp.mean(xf, axis=-1, keepdims=True)
    var = jnp.mean(jnp.square(xf - mu), axis=-1, keepdims=True)
    y = (xf - mu) * lax.rsqrt(var + LN_EPS)
    return (y * g.astype(jnp.float32) + b.astype(jnp.float32)).astype(x.dtype)


def _real_linear_scan(a, b):
    def combine(c1, c2):
        a1, b1 = c1
        a2, b2 = c2
        return a1 * a2, a2 * b1 + b2
    _, h = lax.associative_scan(combine, (a, b), axis=1)
    return h


def _complex_linear_scan(a_re, a_im, b_re, b_im):
    def combine(c1, c2):
        a1r, a1i, b1r, b1i = c1
        a2r, a2i, b2r, b2i = c2
        ar = a2r * a1r - a2i * a1i
        ai = a2r * a1i + a2i * a1r
        br = a2r * b1r - a2i * b1i + b2r
        bi = a2r * b1i + a2i * b1r + b2i
        return ar, ai, br, bi
    _, _, h_re, h_im = lax.associative_scan(combine, (a_re, a_im, b_re, b_im), axis=1)
    return h_re, h_im


def _causal_depthwise_conv(x, w, bias):
    c = x.shape[-1]
    y = lax.conv_general_dilated(
        x, w[:, None, :].astype(x.dtype), window_strides=(1,),
        padding=[(CONV_WIDTH - 1, 0)], dimension_numbers=("NWC", "WIO", "NWC"),
        feature_group_count=c)
    return y + bias


def _rglru_branch(xr, gate, conv_w, conv_b, wa, ba, wx, bx, lam, w_a_out):
    bsz, s, _ = xr.shape
    xc = _causal_depthwise_conv(xr, conv_w, conv_b)
    xh = xc.reshape(bsz, s, RG_HEADS, RG_HEAD_DIM)
    r = jax.nn.sigmoid(jnp.einsum("bshi,hij->bshj", xh, wa) + ba).reshape(bsz, s, D_RNN)
    i = jax.nn.sigmoid(jnp.einsum("bshi,hij->bshj", xh, wx) + bx).reshape(bsz, s, D_RNN)
    log_a = (-RG_C * r.astype(jnp.float32)) * jax.nn.softplus(-lam.astype(jnp.float32))
    a = jnp.exp(log_a)
    mult = jnp.sqrt(-jnp.expm1(2.0 * log_a))
    b = mult * (i.astype(jnp.float32) * xc.astype(jnp.float32))
    h = _real_linear_scan(a, b).astype(xr.dtype)
    return (h * jax.nn.gelu(gate)) @ w_a_out


def _s5_branch(u, a_re, a_im, log_dt, b_re, b_im, c_re, c_im, d, glu_w, glu_v):
    bsz, s, _ = u.shape
    uf = u.astype(jnp.float32).reshape(bsz, s, SSM_GROUPS, SSM_GROUP)
    dt = jnp.exp(log_dt.astype(jnp.float32))[:, None]
    lr = jnp.minimum(a_re.astype(jnp.float32), -1e-4)
    li = a_im.astype(jnp.float32)
    mag = jnp.exp(lr * dt)
    lbr = mag * jnp.cos(li * dt)
    lbi = mag * jnp.sin(li * dt)
    zr, zi = lbr - 1.0, lbi
    den = lr * lr + li * li
    fr = (zr * lr + zi * li) / den
    fi = (zi * lr - zr * li) / den
    br32, bi32 = b_re.astype(jnp.float32), b_im.astype(jnp.float32)
    bbr = fr[..., None] * br32 - fi[..., None] * bi32
    bbi = fr[..., None] * bi32 + fi[..., None] * br32
    bu_re = jnp.einsum("bsgh,gph->bsgp", uf, bbr)
    bu_im = jnp.einsum("bsgh,gph->bsgp", uf, bbi)
    shp = (1, s, SSM_GROUPS, SSM_STATE)
    h_re, h_im = _complex_linear_scan(jnp.broadcast_to(lbr, shp), jnp.broadcast_to(lbi, shp),
                                      bu_re, bu_im)
    y = (jnp.einsum("bsgp,ghp->bsgh", h_re, c_re.astype(jnp.float32))
         - jnp.einsum("bsgp,ghp->bsgh", h_im, c_im.astype(jnp.float32))
         + d.astype(jnp.float32) * uf)
    y = jax.nn.gelu(y.reshape(bsz, s, D_SSM)).astype(u.dtype)
    return (y @ glu_w) * jax.nn.sigmoid(y @ glu_v)


def setup_inputs(seed: int = 0) -> dict:
    key = jax.random.key(seed)
    ks = jax.random.split(key, 32)
    L = DEPTH
    beta = (8.0 * DEPTH) ** -0.25

    def nrm(k, shape, scale):
        return jax.random.normal(k, shape, jnp.float32) * scale

    x = nrm(ks[0], (BATCH, SEQ, D_MODEL), 1.0)
    w_in = nrm(ks[1], (L, D_MODEL, D_IN), D_MODEL ** -0.5)
    conv_w = nrm(ks[2], (L, CONV_WIDTH, D_RNN), CONV_WIDTH ** -0.5)
    conv_b = nrm(ks[3], (L, D_RNN), 0.01)
    rg_wa = nrm(ks[4], (L, RG_HEADS, RG_HEAD_DIM, RG_HEAD_DIM), RG_HEAD_DIM ** -0.5)
    rg_ba = nrm(ks[5], (L, RG_HEADS, RG_HEAD_DIM), 0.01)
    rg_wx = nrm(ks[6], (L, RG_HEADS, RG_HEAD_DIM, RG_HEAD_DIM), RG_HEAD_DIM ** -0.5)
    rg_bx = nrm(ks[7], (L, RG_HEADS, RG_HEAD_DIM), 0.01)
    a_c = jax.random.uniform(ks[8], (L, D_RNN), jnp.float32, 0.9, 0.999)
    a0 = a_c ** (1.0 / RG_C)
    rg_lambda = jnp.log(a0) - jnp.log1p(-a0)
    w_a_out = nrm(ks[9], (L, D_RNN, D_MODEL), D_RNN ** -0.5)
    n = jnp.arange(SSM_STATE, dtype=jnp.float32)
    ssm_a_re = -0.5 + nrm(ks[10], (L, SSM_GROUPS, SSM_STATE), 0.01)
    ssm_a_im = math.pi * n + nrm(ks[11], (L, SSM_GROUPS, SSM_STATE), 0.01)
    ssm_log_dt = jax.random.uniform(ks[12], (L, SSM_GROUPS), jnp.float32,
                                    math.log(1e-3), math.log(1e-1))
    ssm_b_re = nrm(ks[13], (L, SSM_GROUPS, SSM_STATE, SSM_GROUP), (2.0 * SSM_GROUP) ** -0.5)
    ssm_b_im = nrm(ks[14], (L, SSM_GROUPS, SSM_STATE, SSM_GROUP), (2.0 * SSM_GROUP) ** -0.5)
    ssm_c_re = nrm(ks[15], (L, SSM_GROUPS, SSM_GROUP, SSM_STATE), (0.5 * SSM_STATE) ** -0.5)
    ssm_c_im = nrm(ks[16], (L, SSM_GROUPS, SSM_GROUP, SSM_STATE), (0.5 * SSM_STATE) ** -0.5)
    ssm_d = nrm(ks[17], (L, SSM_GROUPS, SSM_GROUP), 1.0)
    glu_w = nrm(ks[18], (L, D_SSM, D_MODEL), D_SSM ** -0.5)
    glu_v = nrm(ks[19], (L, D_SSM, D_MODEL), D_SSM ** -0.5)
    w_out = nrm(ks[20], (L, D_MODEL, D_MODEL), beta * D_MODEL ** -0.5)
    ln1_g = 1.0 + nrm(ks[21], (L, D_MODEL), 0.02)
    ln1_b = nrm(ks[22], (L, D_MODEL), 0.02)
    mlp_w_up = nrm(ks[23], (L, D_MODEL, D_FF), beta * D_MODEL ** -0.5)
    mlp_b_up = nrm(ks[24], (L, D_FF), 0.01)
    mlp_w_down = nrm(ks[25], (L, D_FF, D_MODEL), beta * D_FF ** -0.5)
    mlp_b_down = nrm(ks[26], (L, D_MODEL), 0.01)
    ln2_g = 1.0 + nrm(ks[27], (L, D_MODEL), 0.02)
    ln2_b = nrm(ks[28], (L, D_MODEL), 0.02)
    return {"x": x, "w_in": w_in, "conv_w": conv_w, "conv_b": conv_b,
            "rg_wa": rg_wa, "rg_ba": rg_ba, "rg_wx": rg_wx, "rg_bx": rg_bx,
            "rg_lambda": rg_lambda, "w_a_out": w_a_out,
            "ssm_a_re": ssm_a_re, "ssm_a_im": ssm_a_im, "ssm_log_dt": ssm_log_dt,
            "ssm_b_re": ssm_b_re, "ssm_b_im": ssm_b_im, "ssm_c_re": ssm_c_re,
            "ssm_c_im": ssm_c_im, "ssm_d": ssm_d, "glu_w": glu_w, "glu_v": glu_v,
            "w_out": w_out, "ln1_g": ln1_g, "ln1_b": ln1_b,
            "mlp_w_up": mlp_w_up, "mlp_b_up": mlp_b_up, "mlp_w_down": mlp_w_down,
            "mlp_b_down": mlp_b_down, "ln2_g": ln2_g, "ln2_b": ln2_b}


def reference(x, w_in, conv_w, conv_b, rg_wa, rg_ba, rg_wx, rg_bx, rg_lambda, w_a_out,
              ssm_a_re, ssm_a_im, ssm_log_dt, ssm_b_re, ssm_b_im, ssm_c_re, ssm_c_im,
              ssm_d, glu_w, glu_v, w_out, ln1_g, ln1_b, mlp_w_up, mlp_b_up,
              mlp_w_down, mlp_b_down, ln2_g, ln2_b):
    alpha = (2.0 * DEPTH) ** 0.25
    splits = [D_RNN, 2 * D_RNN, 2 * D_RNN + D_SSM, 2 * D_RNN + D_SSM + D_MODEL]
    for l in range(DEPTH):
        z = x @ w_in[l]
        xr, gate_r, u_s, g_a, g_b = jnp.split(z, splits, axis=-1)
        y_a = _rglru_branch(xr, gate_r, conv_w[l], conv_b[l], rg_wa[l], rg_ba[l],
                            rg_wx[l], rg_bx[l], rg_lambda[l], w_a_out[l])
        y_b = _s5_branch(u_s, ssm_a_re[l], ssm_a_im[l], ssm_log_dt[l], ssm_b_re[l],
                         ssm_b_im[l], ssm_c_re[l], ssm_c_im[l], ssm_d[l], glu_w[l], glu_v[l])
        mix = jax.nn.sigmoid(g_a) * y_a + jax.nn.sigmoid(g_b) * y_b
        x = _layernorm(alpha * x + mix @ w_out[l], ln1_g[l], ln1_b[l])
        h = jnp.square(jax.nn.relu(x @ mlp_w_up[l] + mlp_b_up[l])) @ mlp_w_down[l] + mlp_b_down[l]
        x = _layernorm(alpha * x + h, ln2_g[l], ln2_b[l])
    return x
```

```cpp
#include <hip/hip_runtime.h>
#include <cstdio>
#include <cstdint>

typedef unsigned short bf16_t;
constexpr int NB = 2, SEQ = 8192, M = NB * SEQ, D = 2048, HEADS = 16, HD = 128, DSSM = 1024, NG = 64, GS = 16, NP = 64, DFF = 8192, DIN = 9216;
constexpr int O_XR = 0, O_GR = 2048, O_U = 4096, O_GA = 5120, O_GB = 7168;
constexpr float ALPHA = 1.189207115002721f;
constexpr float LN_EPS = 1e-5f;
enum { I_X = 0, I_WIN, I_CONVW, I_CONVB, I_WA, I_BA, I_WX, I_BX, I_LAM, I_WAOUT, I_ARE, I_AIM, I_LOGDT, I_BRE, I_BIM, I_CRE, I_CIM, I_SD, I_GLUW, I_GLUV, I_WOUT,
       I_LN1G, I_LN1B, I_WUP, I_BUP, I_WDOWN, I_BDOWN, I_LN2G, I_LN2B, N_IN };

constexpr size_t MiB = 1u << 20;
constexpr size_t WS_CTL = 0;
constexpr size_t WS_S5LAM = 1 * MiB;
constexpr size_t WS_S5BBR = WS_S5LAM + 64 * 1024;
constexpr size_t WS_S5BBI = WS_S5BBR + 256 * 1024;
constexpr size_t WS_WIN = 2 * MiB;
constexpr size_t WS_WA = WS_WIN + 36 * MiB;
constexpr size_t WS_WGLU = WS_WA + 8 * MiB;
constexpr size_t WS_WOUT = WS_WGLU + 8 * MiB;
constexpr size_t WS_WUP = WS_WOUT + 8 * MiB;
constexpr size_t WS_WDOWN = WS_WUP + 32 * MiB;
constexpr size_t WS_X1B = WS_WDOWN + 32 * MiB;
constexpr size_t WS_Z = WS_X1B + 64 * MiB;
constexpr size_t WS_END = WS_Z + 288 * MiB;

__device__ __forceinline__ bf16_t f2bf(float f) { unsigned u = __float_as_uint(f); u += 0x7fffu + ((u >> 16) & 1u); return (bf16_t)(u >> 16); }
__device__ __forceinline__ float bf2f(bf16_t b) { return __uint_as_float(((unsigned)b) << 16); }
__device__ __forceinline__ float sigmoid_f(float x) { return 1.f / (1.f + __expf(-x)); }
__device__ __forceinline__ float gelu_tanh(float x) { const float u = 1.5957691216057308f * (x + 0.044715f * x * x * x); return x * sigmoid_f(u); }

namespace nv {
__device__ __forceinline__ int rowmap(int mode, int n) { return mode == 0 ? n : ((n >> 7) * 256 + (mode == 2 ? 128 : 0) + (n & 127)); }
__global__ void k_transpose(const float* __restrict__ W, int K, int N, bf16_t* __restrict__ Wt, int mode) {
    __shared__ float tile[32][33];
    const int n0 = blockIdx.x * 32, k0 = blockIdx.y * 32;
    for (int i = threadIdx.y; i < 32; i += 8) tile[i][threadIdx.x] = W[(size_t)(k0 + i) * N + n0 + threadIdx.x];
    __syncthreads();
    for (int i = threadIdx.y; i < 32; i += 8) { const int row = rowmap(mode, n0 + i); Wt[(size_t)row * K + k0 + threadIdx.x] = f2bf(tile[threadIdx.x][i]); }
}
__global__ void k_cvt(const float* __restrict__ x, bf16_t* __restrict__ xb, size_t n) {
    for (size_t i = (size_t)blockIdx.x * blockDim.x + threadIdx.x; i < n; i += (size_t)gridDim.x * blockDim.x) xb[i] = f2bf(x[i]);
}
__global__ void k_s5_params(const float* a_re, const float* a_im, const float* log_dt, const float* b_re, const float* b_im, float2* lam, float* bbr, float* bbi) {
    const int idx = blockIdx.x * blockDim.x + threadIdx.x; if (idx >= NG * NP) return;
    const int g = idx / NP;
    const double dt = exp((double)log_dt[g]);
    const double lr = fmin((double)a_re[idx], -1e-4), li = (double)a_im[idx];
    const double mag = exp(lr * dt), lbr = mag * cos(li * dt), lbi = mag * sin(li * dt);
    const double zr = lbr - 1.0, zi = lbi, den = lr * lr + li * li;
    const double fr = (zr * lr + zi * li) / den, fi = (zi * lr - zr * li) / den;
    lam[idx] = make_float2((float)lbr, (float)lbi);
    for (int h = 0; h < GS; ++h) { const double br = b_re[idx * GS + h], bi = b_im[idx * GS + h];
        bbr[idx * GS + h] = (float)(fr * br - fi * bi); bbi[idx * GS + h] = (float)(fr * bi + fi * br); }
}
template <class Epi> __global__ void __launch_bounds__(256) k_gemm(const bf16_t* __restrict__ A, int lda, const bf16_t* __restrict__ Bt, int ldb, int K, Epi E) {
    __shared__ float As[16][68], Bs[16][68];
    const int tid = threadIdx.x, tx = tid & 15, ty = tid >> 4, m0 = blockIdx.y * 64, n0 = blockIdx.x * 64;
    float acc[4][4];
#pragma unroll
    for (int i = 0; i < 4; ++i)
#pragma unroll
        for (int j = 0; j < 4; ++j) acc[i][j] = 0.f;
    const int lr = tid >> 2, lk = (tid & 3) * 4;
    for (int k0 = 0; k0 < K; k0 += 16) {
        const ushort4 av = *(const ushort4*)(A + (size_t)(m0 + lr) * lda + k0 + lk);
        const ushort4 bv = *(const ushort4*)(Bt + (size_t)(n0 + lr) * ldb + k0 + lk);
        As[lk + 0][lr] = bf2f(av.x); As[lk + 1][lr] = bf2f(av.y); As[lk + 2][lr] = bf2f(av.z); As[lk + 3][lr] = bf2f(av.w);
        Bs[lk + 0][lr] = bf2f(bv.x); Bs[lk + 1][lr] = bf2f(bv.y); Bs[lk + 2][lr] = bf2f(bv.z); Bs[lk + 3][lr] = bf2f(bv.w);
        __syncthreads();
#pragma unroll
        for (int k = 0; k < 16; ++k) {
            const float4 a = *(const float4*)&As[k][ty * 4], b = *(const float4*)&Bs[k][tx * 4];
            const float aa[4] = {a.x, a.y, a.z, a.w}, bb[4] = {b.x, b.y, b.z, b.w};
#pragma unroll
            for (int i = 0; i < 4; ++i)
#pragma unroll
                for (int j = 0; j < 4; ++j) acc[i][j] += aa[i] * bb[j];
        }
        __syncthreads();
    }
#pragma unroll
    for (int i = 0; i < 4; ++i)
#pragma unroll
        for (int j = 0; j < 4; ++j) E(m0 + ty * 4 + i, n0 + tx * 4 + j, acc[i][j]);
}
__global__ void __launch_bounds__(256) k_glu(const bf16_t* __restrict__ A, int lda, const bf16_t* __restrict__ Bt, int K, bf16_t* Z) {
    __shared__ float As[16][68], Bw[16][68], Bv[16][68];
    const int tid = threadIdx.x, tx = tid & 15, ty = tid >> 4, m0 = blockIdx.y * 64, n0 = blockIdx.x * 64;
    float aw[4][4], avv[4][4];
#pragma unroll
    for (int i = 0; i < 4; ++i)
#pragma unroll
        for (int j = 0; j < 4; ++j) { aw[i][j] = 0.f; avv[i][j] = 0.f; }
    const int lr = tid >> 2, lk = (tid & 3) * 4;
    const int rw = rowmap(1, n0 + lr), rv = rowmap(2, n0 + lr);
    for (int k0 = 0; k0 < K; k0 += 16) {
        const ushort4 a4 = *(const ushort4*)(A + (size_t)(m0 + lr) * lda + k0 + lk);
        const ushort4 w4 = *(const ushort4*)(Bt + (size_t)rw * K + k0 + lk);
        const ushort4 v4 = *(const ushort4*)(Bt + (size_t)rv * K + k0 + lk);
        As[lk + 0][lr] = bf2f(a4.x); As[lk + 1][lr] = bf2f(a4.y); As[lk + 2][lr] = bf2f(a4.z); As[lk + 3][lr] = bf2f(a4.w);
        Bw[lk + 0][lr] = bf2f(w4.x); Bw[lk + 1][lr] = bf2f(w4.y); Bw[lk + 2][lr] = bf2f(w4.z); Bw[lk + 3][lr] = bf2f(w4.w);
        Bv[lk + 0][lr] = bf2f(v4.x); Bv[lk + 1][lr] = bf2f(v4.y); Bv[lk + 2][lr] = bf2f(v4.z); Bv[lk + 3][lr] = bf2f(v4.w);
        __syncthreads();
#pragma unroll
        for (int k = 0; k < 16; ++k) {
            const float4 a = *(const float4*)&As[k][ty * 4], w = *(const float4*)&Bw[k][tx * 4], v = *(const float4*)&Bv[k][tx * 4];
            const float aa[4] = {a.x, a.y, a.z, a.w}, ww[4] = {w.x, w.y, w.z, w.w}, vv[4] = {v.x, v.y, v.z, v.w};
#pragma unroll
            for (int i = 0; i < 4; ++i)
#pragma unroll
                for (int j = 0; j < 4; ++j) { aw[i][j] += aa[i] * ww[j]; avv[i][j] += aa[i] * vv[j]; }
        }
        __syncthreads();
    }
#pragma unroll
    for (int i = 0; i < 4; ++i)
#pragma unroll
        for (int j = 0; j < 4; ++j) { const int row = m0 + ty * 4 + i, col = n0 + tx * 4 + j; bf16_t* p = Z + (size_t)row * DIN + O_GB + col;
            *p = f2bf(aw[i][j] * sigmoid_f(avv[i][j]) * bf2f(*p)); }
}
__global__ void __launch_bounds__(128) k_rglru(bf16_t* Z, const float* conv_w, const float* conv_b, const float* wa, const float* ba, const float* wx, const float* bx, const float* lam) {
    extern __shared__ float sm[];
    float* s_wa = sm; float* s_wx = sm + HD * HD; float* s_xc = sm + 2 * HD * HD;
    const int b = blockIdx.x / HEADS, hd = blockIdx.x % HEADS, j = threadIdx.x, ch = hd * HD + j;
    for (int i = j; i < HD * HD; i += 128) { s_wa[i] = wa[(size_t)hd * HD * HD + i]; s_wx[i] = wx[(size_t)hd * HD * HD + i]; }
    const float cw0 = conv_w[0 * D + ch], cw1 = conv_w[1 * D + ch], cw2 = conv_w[2 * D + ch], cw3 = conv_w[3 * D + ch], cb = conv_b[ch];
    const float bav = ba[ch], bxv = bx[ch];
    const float lac = -8.f * log1pf(expf(-lam[ch]));
    float x1 = 0.f, x2 = 0.f, x3 = 0.f, h = 0.f;
    __syncthreads();
    bf16_t* zr = Z + (size_t)b * SEQ * DIN;
    for (int t = 0; t < SEQ; ++t) {
        const float x0 = bf2f(zr[(size_t)t * DIN + O_XR + ch]);
        const float xc = cw0 * x3 + cw1 * x2 + cw2 * x1 + cw3 * x0 + cb;
        x3 = x2; x2 = x1; x1 = x0;
        s_xc[j] = xc;
        __syncthreads();
        float rp = bav, ip = bxv;
#pragma unroll 8
        for (int i = 0; i < HD; ++i) { const float v = s_xc[i]; rp += v * s_wa[i * HD + j]; ip += v * s_wx[i * HD + j]; }
        __syncthreads();
        const float r = sigmoid_f(rp), ig = sigmoid_f(ip);
        const float la = r * lac, a = expf(la), mult = sqrtf(-expm1f(2.f * la));
        h = a * h + mult * (ig * xc);
        bf16_t* g = zr + (size_t)t * DIN + O_GR + ch;
        *g = f2bf(h * bf2f(*g));
    }
}
__global__ void __launch_bounds__(64) k_s5(bf16_t* Z, const float2* lamb, const float* bbr, const float* bbi, const float* c_re, const float* c_im, const float* dd) {
    const int b = blockIdx.x / NG, g = blockIdx.x % NG, p = threadIdx.x;
    float br[GS], bi[GS], cr[GS], ci[GS];
#pragma unroll
    for (int h = 0; h < GS; ++h) { br[h] = bbr[(g * NP + p) * GS + h]; bi[h] = bbi[(g * NP + p) * GS + h]; cr[h] = c_re[(g * GS + h) * NP + p]; ci[h] = c_im[(g * GS + h) * NP + p]; }
    const float2 l = lamb[g * NP + p];
    const float dv = dd[g * GS + (p & 15)];
    float hr = 0.f, hi = 0.f;
    bf16_t* zr = Z + (size_t)b * SEQ * DIN + O_U + g * GS;
    for (int t = 0; t < SEQ; ++t) {
        const float ul = bf2f(zr[(size_t)t * DIN + (p & 15)]);
        float bur = 0.f, bui = 0.f;
#pragma unroll
        for (int h = 0; h < GS; ++h) { const float u = __shfl(ul, h); bur += br[h] * u; bui += bi[h] * u; }
        const float nr = l.x * hr - l.y * hi + bur, ni = l.x * hi + l.y * hr + bui; hr = nr; hi = ni;
        float yv = 0.f;
#pragma unroll
        for (int h = 0; h < GS; ++h) { float v = cr[h] * hr - ci[h] * hi;
#pragma unroll
            for (int o = 1; o < 64; o <<= 1) v += __shfl_xor(v, o);
            yv = (p == h) ? v : yv; }
        if (p < GS) zr[(size_t)t * DIN + p] = f2bf(gelu_tanh(yv + dv * ul));
    }
}
__global__ void __launch_bounds__(256) k_ln(float* X, const float* g, const float* bt, bf16_t* xb) {
    __shared__ float red[8];
    const int row = blockIdx.x, tid = threadIdx.x; float* xr = X + (size_t)row * D;
    float v[8]; float s = 0.f;
#pragma unroll
    for (int i = 0; i < 8; ++i) { v[i] = xr[tid + 256 * i]; s += v[i]; }
#pragma unroll
    for (int o = 1; o < 64; o <<= 1) s += __shfl_xor(s, o);
    if ((tid & 63) == 0) red[tid >> 6] = s;
    __syncthreads();
    const float mean = (red[0] + red[1] + red[2] + red[3]) * (1.f / D);
    float q = 0.f;
#pragma unroll
    for (int i = 0; i < 8; ++i) { v[i] -= mean; q += v[i] * v[i]; }
#pragma unroll
    for (int o = 1; o < 64; o <<= 1) q += __shfl_xor(q, o);
    if ((tid & 63) == 0) red[4 + (tid >> 6)] = q;
    __syncthreads();
    const float rstd = rsqrtf((red[4] + red[5] + red[6] + red[7]) * (1.f / D) + LN_EPS);
#pragma unroll
    for (int i = 0; i < 8; ++i) { const int c = tid + 256 * i; const float y = v[i] * rstd * g[c] + bt[c]; xr[c] = y; if (xb) xb[(size_t)row * D + c] = f2bf(y); }
}
struct EpiZ { bf16_t* Z; __device__ void operator()(int r, int c, float a) const {
    float v = a; if (c >= O_GR && c < O_U) v = gelu_tanh(a); else if (c >= O_GA) v = sigmoid_f(a); Z[(size_t)r * DIN + c] = f2bf(v); } };
struct EpiMix { bf16_t* Z; __device__ void operator()(int r, int c, float a) const {
    bf16_t* p = Z + (size_t)r * DIN + O_GA + c; *p = f2bf(bf2f(*p) * a + bf2f(Z[(size_t)r * DIN + O_GB + c])); } };
struct EpiR1 { const float* x; float* out; __device__ void operator()(int r, int c, float a) const { out[(size_t)r * D + c] = ALPHA * x[(size_t)r * D + c] + a; } };
struct EpiUp { bf16_t* H; const float* b; __device__ void operator()(int r, int c, float a) const { const float v = fmaxf(a + b[c], 0.f); H[(size_t)r * DFF + c] = f2bf(v * v); } };
struct EpiR2 { float* out; const float* b; __device__ void operator()(int r, int c, float a) const { float* p = out + (size_t)r * D + c; *p = ALPHA * (*p) + a + b[c]; } };
}

extern "C" void kernel_launch(void* const* d_in, const int* in_sizes, int n_in, void* d_out, int out_size, void* d_ws, size_t ws_size, hipStream_t stream) {
    if (n_in != N_IN || out_size != M * D || ws_size < WS_END) { fprintf(stderr, "kernel_launch: unexpected shapes (n_in %d out %d ws %zu)\n", n_in, out_size, ws_size); return; }
    const float* in[N_IN]; for (int i = 0; i < N_IN; ++i) in[i] = (const float*)d_in[i];
    unsigned char* ws = (unsigned char*)d_ws; float* out = (float*)d_out;
    bf16_t *Wt_in = (bf16_t*)(ws + WS_WIN), *Wt_a = (bf16_t*)(ws + WS_WA), *Wt_glu = (bf16_t*)(ws + WS_WGLU), *Wt_out = (bf16_t*)(ws + WS_WOUT), *Wt_up = (bf16_t*)(ws + WS_WUP), *Wt_down = (bf16_t*)(ws + WS_WDOWN);
    bf16_t *X1B = (bf16_t*)(ws + WS_X1B), *Z = (bf16_t*)(ws + WS_Z), *HMID = (bf16_t*)(ws + WS_Z), *XB = (bf16_t*)d_out;
    float2* s5lam = (float2*)(ws + WS_S5LAM); float* s5bbr = (float*)(ws + WS_S5BBR); float* s5bbi = (float*)(ws + WS_S5BBI);
    const dim3 tb(32, 8);
    nv::k_transpose<<<dim3(DIN / 32, D / 32), tb, 0, stream>>>(in[I_WIN], D, DIN, Wt_in, 0);
    nv::k_transpose<<<dim3(D / 32, D / 32), tb, 0, stream>>>(in[I_WAOUT], D, D, Wt_a, 0);
    nv::k_transpose<<<dim3(D / 32, DSSM / 32), tb, 0, stream>>>(in[I_GLUW], DSSM, D, Wt_glu, 1);
    nv::k_transpose<<<dim3(D / 32, DSSM / 32), tb, 0, stream>>>(in[I_GLUV], DSSM, D, Wt_glu, 2);
    nv::k_transpose<<<dim3(D / 32, D / 32), tb, 0, stream>>>(in[I_WOUT], D, D, Wt_out, 0);
    nv::k_transpose<<<dim3(DFF / 32, D / 32), tb, 0, stream>>>(in[I_WUP], D, DFF, Wt_up, 0);
    nv::k_transpose<<<dim3(D / 32, DFF / 32), tb, 0, stream>>>(in[I_WDOWN], DFF, D, Wt_down, 0);
    nv::k_cvt<<<2048, 256, 0, stream>>>(in[I_X], XB, (size_t)M * D);
    nv::k_s5_params<<<(NG * NP + 255) / 256, 256, 0, stream>>>(in[I_ARE], in[I_AIM], in[I_LOGDT], in[I_BRE], in[I_BIM], s5lam, s5bbr, s5bbi);
    nv::k_gemm<nv::EpiZ><<<dim3(DIN / 64, M / 64), 256, 0, stream>>>(XB, D, Wt_in, D, D, nv::EpiZ{Z});
    static bool attr = false; const int rg_lds = (2 * HD * HD + HD) * 4;
    if (!attr) { hipFuncSetAttribute((const void*)nv::k_rglru, hipFuncAttributeMaxDynamicSharedMemorySize, rg_lds); attr = true; }
    nv::k_rglru<<<NB * HEADS, 128, rg_lds, stream>>>(Z, in[I_CONVW], in[I_CONVB], in[I_WA], in[I_BA], in[I_WX], in[I_BX], in[I_LAM]);
    nv::k_s5<<<NB * NG, 64, 0, stream>>>(Z, s5lam, s5bbr, s5bbi, in[I_CRE], in[I_CIM], in[I_SD]);
    nv::k_glu<<<dim3(D / 64, M / 64), 256, 0, stream>>>(Z + O_U, DIN, Wt_glu, DSSM, Z);
    nv::k_gemm<nv::EpiMix><<<dim3(D / 64, M / 64), 256, 0, stream>>>(Z + O_GR, DIN, Wt_a, D, D, nv::EpiMix{Z});
    nv::k_gemm<nv::EpiR1><<<dim3(D / 64, M / 64), 256, 0, stream>>>(Z + O_GA, DIN, Wt_out, D, D, nv::EpiR1{in[I_X], out});
    nv::k_ln<<<M, 256, 0, stream>>>(out, in[I_LN1G], in[I_LN1B], X1B);
    nv::k_gemm<nv::EpiUp><<<dim3(DFF / 64, M / 64), 256, 0, stream>>>(X1B, D, Wt_up, D, D, nv::EpiUp{HMID, in[I_BUP]});
    nv::k_gemm<nv::EpiR2><<<dim3(D / 64, M / 64), 256, 0, stream>>>(HMID, DFF, Wt_down, DFF, DFF, nv::EpiR2{out, in[I_BDOWN]});
    nv::k_ln<<<M, 256, 0, stream>>>(out, in[I_LN2G], in[I_LN2B], nullptr);
}
```

```cpp
#include <hip/hip_runtime.h>
#include <hip/hip_cooperative_groups.h>
#include <cstdio>
#include <cstdint>

typedef unsigned short bf16_t;
constexpr int NB = 2, SEQ = 8192, M = NB * SEQ, D = 2048, HEADS = 16, HD = 128, DSSM = 1024, NG = 64, GS = 16, NP = 64, DFF = 8192, DIN = 9216;
constexpr int O_XR = 0, O_GR = 2048, O_U = 4096, O_GA = 5120, O_GB = 7168;
constexpr float ALPHA = 1.189207115002721f;
constexpr float LN_EPS = 1e-5f;
enum { I_X = 0, I_WIN, I_CONVW, I_CONVB, I_WA, I_BA, I_WX, I_BX, I_LAM, I_WAOUT, I_ARE, I_AIM, I_LOGDT, I_BRE, I_BIM, I_CRE, I_CIM, I_SD, I_GLUW, I_GLUV, I_WOUT,
       I_LN1G, I_LN1B, I_WUP, I_BUP, I_WDOWN, I_BDOWN, I_LN2G, I_LN2B, N_IN };

constexpr size_t MiB = 1u << 20;
constexpr size_t WS_CTL = 0;
constexpr size_t WS_S5LAM = 1 * MiB;
constexpr size_t WS_S5BBR = WS_S5LAM + 64 * 1024;
constexpr size_t WS_S5BBI = WS_S5BBR + 256 * 1024;
constexpr size_t WS_WIN = 2 * MiB;
constexpr size_t WS_WA = WS_WIN + 36 * MiB;
constexpr size_t WS_WGLU = WS_WA + 8 * MiB;
constexpr size_t WS_WOUT = WS_WGLU + 8 * MiB;
constexpr size_t WS_WUP = WS_WOUT + 8 * MiB;
constexpr size_t WS_WDOWN = WS_WUP + 32 * MiB;
constexpr size_t WS_X1B = WS_WDOWN + 32 * MiB;
constexpr size_t WS_Z = WS_X1B + 64 * MiB;
constexpr size_t WS_RGW = WS_Z + 288 * MiB;
constexpr size_t WS_END = WS_RGW + 1 * MiB;

__device__ __forceinline__ bf16_t f2bf(float f) { unsigned u = __float_as_uint(f); u += 0x7fffu + ((u >> 16) & 1u); return (bf16_t)(u >> 16); }
__device__ __forceinline__ float bf2f(bf16_t b) { return __uint_as_float(((unsigned)b) << 16); }
__device__ __forceinline__ float sigmoid_f(float x) { return 1.f / (1.f + __expf(-x)); }
__device__ __forceinline__ float gelu_tanh(float x) { const float u = 1.5957691216057308f * (x + 0.044715f * x * x * x); return x * sigmoid_f(u); }

namespace nv {
__device__ __forceinline__ int rowmap(int mode, int n) { return mode == 0 ? n : ((n >> 7) * 256 + (mode == 2 ? 128 : 0) + (n & 127)); }
__global__ void k_transpose(const float* __restrict__ W, int K, int N, bf16_t* __restrict__ Wt, int mode) {
    __shared__ float tile[32][33];
    const int n0 = blockIdx.x * 32, k0 = blockIdx.y * 32;
    for (int i = threadIdx.y; i < 32; i += 8) tile[i][threadIdx.x] = W[(size_t)(k0 + i) * N + n0 + threadIdx.x];
    __syncthreads();
    for (int i = threadIdx.y; i < 32; i += 8) { const int row = rowmap(mode, n0 + i); Wt[(size_t)row * K + k0 + threadIdx.x] = f2bf(tile[threadIdx.x][i]); }
}
__global__ void k_cvt(const float* __restrict__ x, bf16_t* __restrict__ xb, size_t n) {
    for (size_t i = (size_t)blockIdx.x * blockDim.x + threadIdx.x; i < n; i += (size_t)gridDim.x * blockDim.x) xb[i] = f2bf(x[i]);
}
__global__ void k_s5_params(const float* a_re, const float* a_im, const float* log_dt, const float* b_re, const float* b_im, float2* lam, float* bbr, float* bbi) {
    const int idx = blockIdx.x * blockDim.x + threadIdx.x; if (idx >= NG * NP) return;
    const int g = idx / NP;
    const double dt = exp((double)log_dt[g]);
    const double lr = fmin((double)a_re[idx], -1e-4), li = (double)a_im[idx];
    const double mag = exp(lr * dt), lbr = mag * cos(li * dt), lbi = mag * sin(li * dt);
    const double zr = lbr - 1.0, zi = lbi, den = lr * lr + li * li;
    const double fr = (zr * lr + zi * li) / den, fi = (zi * lr - zr * li) / den;
    lam[idx] = make_float2((float)lbr, (float)lbi);
    for (int h = 0; h < GS; ++h) { const double br = b_re[idx * GS + h], bi = b_im[idx * GS + h];
        bbr[idx * GS + h] = (float)(fr * br - fi * bi); bbi[idx * GS + h] = (float)(fr * bi + fi * br); }
}
template <class Epi> __global__ void __launch_bounds__(256) k_gemm(const bf16_t* __restrict__ A, int lda, const bf16_t* __restrict__ Bt, int ldb, int K, Epi E) {
    __shared__ float As[16][68], Bs[16][68];
    const int tid = threadIdx.x, tx = tid & 15, ty = tid >> 4, m0 = blockIdx.y * 64, n0 = blockIdx.x * 64;
    float acc[4][4];
#pragma unroll
    for (int i = 0; i < 4; ++i)
#pragma unroll
        for (int j = 0; j < 4; ++j) acc[i][j] = 0.f;
    const int lr = tid >> 2, lk = (tid & 3) * 4;
    for (int k0 = 0; k0 < K; k0 += 16) {
        const ushort4 av = *(const ushort4*)(A + (size_t)(m0 + lr) * lda + k0 + lk);
        const ushort4 bv = *(const ushort4*)(Bt + (size_t)(n0 + lr) * ldb + k0 + lk);
        As[lk + 0][lr] = bf2f(av.x); As[lk + 1][lr] = bf2f(av.y); As[lk + 2][lr] = bf2f(av.z); As[lk + 3][lr] = bf2f(av.w);
        Bs[lk + 0][lr] = bf2f(bv.x); Bs[lk + 1][lr] = bf2f(bv.y); Bs[lk + 2][lr] = bf2f(bv.z); Bs[lk + 3][lr] = bf2f(bv.w);
        __syncthreads();
#pragma unroll
        for (int k = 0; k < 16; ++k) {
            const float4 a = *(const float4*)&As[k][ty * 4], b = *(const float4*)&Bs[k][tx * 4];
            const float aa[4] = {a.x, a.y, a.z, a.w}, bb[4] = {b.x, b.y, b.z, b.w};
#pragma unroll
            for (int i = 0; i < 4; ++i)
#pragma unroll
                for (int j = 0; j < 4; ++j) acc[i][j] += aa[i] * bb[j];
        }
        __syncthreads();
    }
#pragma unroll
    for (int i = 0; i < 4; ++i)
#pragma unroll
        for (int j = 0; j < 4; ++j) E(m0 + ty * 4 + i, n0 + tx * 4 + j, acc[i][j]);
}
__global__ void __launch_bounds__(256) k_glu(const bf16_t* __restrict__ A, int lda, const bf16_t* __restrict__ Bt, int K, bf16_t* Z) {
    __shared__ float As[16][68], Bw[16][68], Bv[16][68];
    const int tid = threadIdx.x, tx = tid & 15, ty = tid >> 4, m0 = blockIdx.y * 64, n0 = blockIdx.x * 64;
    float aw[4][4], avv[4][4];
#pragma unroll
    for (int i = 0; i < 4; ++i)
#pragma unroll
        for (int j = 0; j < 4; ++j) { aw[i][j] = 0.f; avv[i][j] = 0.f; }
    const int lr = tid >> 2, lk = (tid & 3) * 4;
    const int rw = rowmap(1, n0 + lr), rv = rowmap(2, n0 + lr);
    for (int k0 = 0; k0 < K; k0 += 16) {
        const ushort4 a4 = *(const ushort4*)(A + (size_t)(m0 + lr) * lda + k0 + lk);
        const ushort4 w4 = *(const ushort4*)(Bt + (size_t)rw * K + k0 + lk);
        const ushort4 v4 = *(const ushort4*)(Bt + (size_t)rv * K + k0 + lk);
        As[lk + 0][lr] = bf2f(a4.x); As[lk + 1][lr] = bf2f(a4.y); As[lk + 2][lr] = bf2f(a4.z); As[lk + 3][lr] = bf2f(a4.w);
        Bw[lk + 0][lr] = bf2f(w4.x); Bw[lk + 1][lr] = bf2f(w4.y); Bw[lk + 2][lr] = bf2f(w4.z); Bw[lk + 3][lr] = bf2f(w4.w);
        Bv[lk + 0][lr] = bf2f(v4.x); Bv[lk + 1][lr] = bf2f(v4.y); Bv[lk + 2][lr] = bf2f(v4.z); Bv[lk + 3][lr] = bf2f(v4.w);
        __syncthreads();
#pragma unroll
        for (int k = 0; k < 16; ++k) {
            const float4 a = *(const float4*)&As[k][ty * 4], w = *(const float4*)&Bw[k][tx * 4], v = *(const float4*)&Bv[k][tx * 4];
            const float aa[4] = {a.x, a.y, a.z, a.w}, ww[4] = {w.x, w.y, w.z, w.w}, vv[4] = {v.x, v.y, v.z, v.w};
#pragma unroll
            for (int i = 0; i < 4; ++i)
#pragma unroll
                for (int j = 0; j < 4; ++j) { aw[i][j] += aa[i] * ww[j]; avv[i][j] += aa[i] * vv[j]; }
        }
        __syncthreads();
    }
#pragma unroll
    for (int i = 0; i < 4; ++i)
#pragma unroll
        for (int j = 0; j < 4; ++j) { const int row = m0 + ty * 4 + i, col = n0 + tx * 4 + j; bf16_t* p = Z + (size_t)row * DIN + O_GB + col;
            *p = f2bf(aw[i][j] * sigmoid_f(avv[i][j]) * bf2f(*p)); }
}
__global__ void __launch_bounds__(128) k_rglru(bf16_t* Z, const float* conv_w, const float* conv_b, const float* wa, const float* ba, const float* wx, const float* bx, const float* lam) {
    extern __shared__ float sm[];
    float* s_wa = sm; float* s_wx = sm + HD * HD; float* s_xc = sm + 2 * HD * HD;
    const int b = blockIdx.x / HEADS, hd = blockIdx.x % HEADS, j = threadIdx.x, ch = hd * HD + j;
    for (int i = j; i < HD * HD; i += 128) { s_wa[i] = wa[(size_t)hd * HD * HD + i]; s_wx[i] = wx[(size_t)hd * HD * HD + i]; }
    const float cw0 = conv_w[0 * D + ch], cw1 = conv_w[1 * D + ch], cw2 = conv_w[2 * D + ch], cw3 = conv_w[3 * D + ch], cb = conv_b[ch];
    const float bav = ba[ch], bxv = bx[ch];
    const float lac = -8.f * log1pf(expf(-lam[ch]));
    float x1 = 0.f, x2 = 0.f, x3 = 0.f, h = 0.f;
    __syncthreads();
    bf16_t* zr = Z + (size_t)b * SEQ * DIN;
    for (int t = 0; t < SEQ; ++t) {
        const float x0 = bf2f(zr[(size_t)t * DIN + O_XR + ch]);
        const float xc = cw0 * x3 + cw1 * x2 + cw2 * x1 + cw3 * x0 + cb;
        x3 = x2; x2 = x1; x1 = x0;
        s_xc[j] = xc;
        __syncthreads();
        float rp = bav, ip = bxv;
#pragma unroll 8
        for (int i = 0; i < HD; ++i) { const float v = s_xc[i]; rp += v * s_wa[i * HD + j]; ip += v * s_wx[i * HD + j]; }
        __syncthreads();
        const float r = sigmoid_f(rp), ig = sigmoid_f(ip);
        const float la = r * lac, a = expf(la), mult = sqrtf(-expm1f(2.f * la));
        h = a * h + mult * (ig * xc);
        bf16_t* g = zr + (size_t)t * DIN + O_GR + ch;
        *g = f2bf(h * bf2f(*g));
    }
}
__global__ void __launch_bounds__(64) k_s5(bf16_t* Z, const float2* lamb, const float* bbr, const float* bbi, const float* c_re, const float* c_im, const float* dd) {
    const int b = blockIdx.x / NG, g = blockIdx.x % NG, p = threadIdx.x;
    float br[GS], bi[GS], cr[GS], ci[GS];
#pragma unroll
    for (int h = 0; h < GS; ++h) { br[h] = bbr[(g * NP + p) * GS + h]; bi[h] = bbi[(g * NP + p) * GS + h]; cr[h] = c_re[(g * GS + h) * NP + p]; ci[h] = c_im[(g * GS + h) * NP + p]; }
    const float2 l = lamb[g * NP + p];
    const float dv = dd[g * GS + (p & 15)];
    float hr = 0.f, hi = 0.f;
    bf16_t* zr = Z + (size_t)b * SEQ * DIN + O_U + g * GS;
    for (int t = 0; t < SEQ; ++t) {
        const float ul = bf2f(zr[(size_t)t * DIN + (p & 15)]);
        float bur = 0.f, bui = 0.f;
#pragma unroll
        for (int h = 0; h < GS; ++h) { const float u = __shfl(ul, h); bur += br[h] * u; bui += bi[h] * u; }
        const float nr = l.x * hr - l.y * hi + bur, ni = l.x * hi + l.y * hr + bui; hr = nr; hi = ni;
        float yv = 0.f;
#pragma unroll
        for (int h = 0; h < GS; ++h) { float v = cr[h] * hr - ci[h] * hi;
#pragma unroll
            for (int o = 1; o < 64; o <<= 1) v += __shfl_xor(v, o);
            yv = (p == h) ? v : yv; }
        if (p < GS) zr[(size_t)t * DIN + p] = f2bf(gelu_tanh(yv + dv * ul));
    }
}
__global__ void __launch_bounds__(256) k_ln(float* X, const float* g, const float* bt, bf16_t* xb) {
    __shared__ float red[8];
    const int row = blockIdx.x, tid = threadIdx.x; float* xr = X + (size_t)row * D;
    float v[8]; float s = 0.f;
#pragma unroll
    for (int i = 0; i < 8; ++i) { v[i] = xr[tid + 256 * i]; s += v[i]; }
#pragma unroll
    for (int o = 1; o < 64; o <<= 1) s += __shfl_xor(s, o);
    if ((tid & 63) == 0) red[tid >> 6] = s;
    __syncthreads();
    const float mean = (red[0] + red[1] + red[2] + red[3]) * (1.f / D);
    float q = 0.f;
#pragma unroll
    for (int i = 0; i < 8; ++i) { v[i] -= mean; q += v[i] * v[i]; }
#pragma unroll
    for (int o = 1; o < 64; o <<= 1) q += __shfl_xor(q, o);
    if ((tid & 63) == 0) red[4 + (tid >> 6)] = q;
    __syncthreads();
    const float rstd = rsqrtf((red[4] + red[5] + red[6] + red[7]) * (1.f / D) + LN_EPS);
#pragma unroll
    for (int i = 0; i < 8; ++i) { const int c = tid + 256 * i; const float y = v[i] * rstd * g[c] + bt[c]; xr[c] = y; if (xb) xb[(size_t)row * D + c] = f2bf(y); }
}
struct EpiZ { bf16_t* Z; __device__ void operator()(int r, int c, float a) const {
    float v = a; if (c >= O_GR && c < O_U) v = gelu_tanh(a); else if (c >= O_GA) v = sigmoid_f(a); Z[(size_t)r * DIN + c] = f2bf(v); } };
struct EpiMix { bf16_t* Z; __device__ void operator()(int r, int c, float a) const {
    bf16_t* p = Z + (size_t)r * DIN + O_GA + c; *p = f2bf(bf2f(*p) * a + bf2f(Z[(size_t)r * DIN + O_GB + c])); } };
struct EpiR1 { const float* x; float* out; __device__ void operator()(int r, int c, float a) const { out[(size_t)r * D + c] = ALPHA * x[(size_t)r * D + c] + a; } };
struct EpiUp { bf16_t* H; const float* b; __device__ void operator()(int r, int c, float a) const { const float v = fmaxf(a + b[c], 0.f); H[(size_t)r * DFF + c] = f2bf(v * v); } };
struct EpiR2 { float* out; const float* b; __device__ void operator()(int r, int c, float a) const { float* p = out + (size_t)r * D + c; *p = ALPHA * (*p) + a + b[c]; } };
}

namespace pg8 {
#define PG8_LAS __attribute__((address_space(3)))
typedef short bf16x8 __attribute__((ext_vector_type(8)));
typedef float f32x4 __attribute__((ext_vector_type(4)));
typedef unsigned u32x4 __attribute__((ext_vector_type(4)));
typedef unsigned u32x2 __attribute__((ext_vector_type(2)));
constexpr int BM = 256, BK = 64, HALF = 128, HTB = HALF * BK * 2  , STAGE_BYTES = 8 * HTB, NXCD = 8, WGM = 8;
__host__ __device__ __forceinline__ int lds_byte(int r, int c) { const int st = (r >> 4) * 2 + (c >> 5), rr = r & 15, cc = c & 31, ob = rr * 64 + cc * 2; return st * 1024 + (ob ^ (((ob >> 9) & 1) << 5)); }
__host__ __device__ __forceinline__ void stage_rc(int b, int& R, int& C) { const int st = b / 1024, sb = b % 1024, swz = sb ^ (((sb >> 9) & 1) << 5); R = (st >> 1) * 16 + swz / 64; C = (st & 1) * 32 + (swz % 64) / 2; }
__host__ __device__ __forceinline__ int perm32(int rho) { const int n = rho >> 4, i = rho & 15; return 8 * (i >> 2) + 4 * n + (i & 3); }
struct Unit { int pm, pn; };
struct Gemm { const bf16_t* A; int lda; const bf16_t* Bt; int ldb; int M, N, K; };
struct StaticOrder {
    int nM, nN, nwg, G, c;
    __host__ __device__ void init(int M_, int N_, int G_, int c_) { nM = M_ / BM; nN = N_ / BM; nwg = nM * nN; G = G_; c = c_; }
    __host__ __device__ bool next(int i, Unit& u) const {
        const long L = (long)i * G + c; if (L >= nwg) return false;
        int wgid = (int)L; { const int q = nwg / NXCD, r = nwg % NXCD, xcd = wgid % NXCD, off = wgid / NXCD; wgid = (xcd < r ? xcd * (q + 1) : r * (q + 1) + (xcd - r) * q) + off; }
        const int nig = WGM * nN, gid = wgid / nig, fm = gid * WGM, gsz = (nM - fm) < WGM ? (nM - fm) : WGM;
        u.pm = fm + ((wgid % nig) % gsz); u.pn = (wgid % nig) / gsz; return true;
    }
    __device__ __forceinline__ void a_ready(const Unit&) const {}
    __device__ __forceinline__ void done(const Unit&) const {}
};
__device__ __forceinline__ unsigned cvt_pk_bf16(float lo, float hi) { unsigned r; asm volatile("v_cvt_pk_bf16_f32 %0, %1, %2" : "=v"(r) : "v"(lo), "v"(hi)); return r; }
__device__ __forceinline__ float bf_lo(unsigned w) { return __uint_as_float(w << 16); }
__device__ __forceinline__ float bf_hi(unsigned w) { return __uint_as_float(w & 0xffff0000u); }
__device__ __forceinline__ float sigm(float x) { return __builtin_amdgcn_rcpf(1.f + __expf(-x)); }
__device__ __forceinline__ float gelu_t(float x) { const float u = 1.5957691216057308f * (x + 0.044715f * x * x * x); return x * sigm(u); }

struct EpiZ {
    static constexpr bool PERM = true, AFTER_DRAIN = false;
    bf16_t* Z;
    __device__ __forceinline__ void operator()(const f32x4 (&acc)[2][2][4][2], const Unit& u, int wr, int wc, int fr, int fq) const {
        const int row0 = u.pm * BM + wr * 64 + fr, col0 = u.pn * BM + wc * 32 + 8 * fq;
        const int act = (u.pn >= 20) ? 2 : ((u.pn >= 8 && u.pn < 16) ? 1 : 0);
#pragma unroll
        for (int ai = 0; ai < 2; ++ai)
#pragma unroll
            for (int m = 0; m < 4; ++m) { bf16_t* rowp = Z + (size_t)(row0 + ai * HALF + m * 16) * DIN + col0;
#pragma unroll
                for (int bj = 0; bj < 2; ++bj) { f32x4 v0 = acc[ai][bj][m][0], v1 = acc[ai][bj][m][1];
                    if (act == 1) {
#pragma unroll
                        for (int j = 0; j < 4; ++j) { v0[j] = gelu_t(v0[j]); v1[j] = gelu_t(v1[j]); } }
                    else if (act == 2) {
#pragma unroll
                        for (int j = 0; j < 4; ++j) { v0[j] = sigm(v0[j]); v1[j] = sigm(v1[j]); } }
                    u32x4 w; w.x = cvt_pk_bf16(v0[0], v0[1]); w.y = cvt_pk_bf16(v0[2], v0[3]); w.z = cvt_pk_bf16(v1[0], v1[1]); w.w = cvt_pk_bf16(v1[2], v1[3]);
                    *(u32x4*)(rowp + bj * HALF) = w; } }
    }
};
struct EpiGlu {
    static constexpr bool PERM = true, AFTER_DRAIN = false;
    bf16_t* Z;
    __device__ __forceinline__ void operator()(const f32x4 (&acc)[2][2][4][2], const Unit& u, int wr, int wc, int fr, int fq) const {
        const int row0 = u.pm * BM + wr * 64 + fr, col0 = u.pn * HALF + wc * 32 + 8 * fq;
#pragma unroll
        for (int ai = 0; ai < 2; ++ai)
#pragma unroll
            for (int m = 0; m < 4; ++m) { bf16_t* p = Z + (size_t)(row0 + ai * HALF + m * 16) * DIN + O_GB + col0;
                const u32x4 g = *(const u32x4*)p;
                const f32x4 w0 = acc[ai][0][m][0], w1 = acc[ai][0][m][1], v0 = acc[ai][1][m][0], v1 = acc[ai][1][m][1];
                u32x4 o;
                o.x = cvt_pk_bf16(w0[0] * sigm(v0[0]) * bf_lo(g.x), w0[1] * sigm(v0[1]) * bf_hi(g.x));
                o.y = cvt_pk_bf16(w0[2] * sigm(v0[2]) * bf_lo(g.y), w0[3] * sigm(v0[3]) * bf_hi(g.y));
                o.z = cvt_pk_bf16(w1[0] * sigm(v1[0]) * bf_lo(g.z), w1[1] * sigm(v1[1]) * bf_hi(g.z));
                o.w = cvt_pk_bf16(w1[2] * sigm(v1[2]) * bf_lo(g.w), w1[3] * sigm(v1[3]) * bf_hi(g.w));
                *(u32x4*)p = o; }
    }
};
struct EpiMix {
    static constexpr bool PERM = true, AFTER_DRAIN = false;
    bf16_t* Z;
    __device__ __forceinline__ void operator()(const f32x4 (&acc)[2][2][4][2], const Unit& u, int wr, int wc, int fr, int fq) const {
        const int row0 = u.pm * BM + wr * 64 + fr, col0 = u.pn * BM + wc * 32 + 8 * fq;
#pragma unroll
        for (int ai = 0; ai < 2; ++ai)
#pragma unroll
            for (int m = 0; m < 4; ++m) { bf16_t* rowp = Z + (size_t)(row0 + ai * HALF + m * 16) * DIN + col0;
#pragma unroll
                for (int bj = 0; bj < 2; ++bj) { bf16_t* pa = rowp + O_GA + bj * HALF; const bf16_t* pb = rowp + O_GB + bj * HALF;
                    const u32x4 ga = *(const u32x4*)pa, yb = *(const u32x4*)pb; const f32x4 a0 = acc[ai][bj][m][0], a1 = acc[ai][bj][m][1];
                    u32x4 o;
                    o.x = cvt_pk_bf16(bf_lo(ga.x) * a0[0] + bf_lo(yb.x), bf_hi(ga.x) * a0[1] + bf_hi(yb.x));
                    o.y = cvt_pk_bf16(bf_lo(ga.y) * a0[2] + bf_lo(yb.y), bf_hi(ga.y) * a0[3] + bf_hi(yb.y));
                    o.z = cvt_pk_bf16(bf_lo(ga.z) * a1[0] + bf_lo(yb.z), bf_hi(ga.z) * a1[1] + bf_hi(yb.z));
                    o.w = cvt_pk_bf16(bf_lo(ga.w) * a1[2] + bf_lo(yb.w), bf_hi(ga.w) * a1[3] + bf_hi(yb.w));
                    *(u32x4*)pa = o; } }
    }
};
struct EpiR1 {
    static constexpr bool PERM = false, AFTER_DRAIN = false;
    const float* x; float* out;
    __device__ __forceinline__ void operator()(const f32x4 (&acc)[2][2][4][2], const Unit& u, int wr, int wc, int fr, int fq) const {
        const int row0 = u.pm * BM + wr * 64 + fr, col0 = u.pn * BM + wc * 32 + 4 * fq;
#pragma unroll
        for (int ai = 0; ai < 2; ++ai)
#pragma unroll
            for (int m = 0; m < 4; ++m) { const size_t off = (size_t)(row0 + ai * HALF + m * 16) * D + col0;
#pragma unroll
                for (int bj = 0; bj < 2; ++bj)
#pragma unroll
                    for (int n = 0; n < 2; ++n) { const f32x4 xv = *(const f32x4*)(x + off + bj * HALF + n * 16); *(f32x4*)(out + off + bj * HALF + n * 16) = xv * ALPHA + acc[ai][bj][m][n]; }
                asm volatile("" ::: "memory"); }
    }
};
struct EpiUp {
    static constexpr bool PERM = true, AFTER_DRAIN = false;
    bf16_t* H; const float* bias;
    __device__ __forceinline__ void operator()(const f32x4 (&acc)[2][2][4][2], const Unit& u, int wr, int wc, int fr, int fq) const {
        const int row0 = u.pm * BM + wr * 64 + fr, col0 = u.pn * BM + wc * 32 + 8 * fq;
        f32x4 bv[2][2];
#pragma unroll
        for (int bj = 0; bj < 2; ++bj)
#pragma unroll
            for (int n = 0; n < 2; ++n) bv[bj][n] = *(const f32x4*)(bias + col0 + bj * HALF + 4 * n);
#pragma unroll
        for (int ai = 0; ai < 2; ++ai)
#pragma unroll
            for (int m = 0; m < 4; ++m) { bf16_t* rowp = H + (size_t)(row0 + ai * HALF + m * 16) * DFF + col0;
#pragma unroll
                for (int bj = 0; bj < 2; ++bj) { f32x4 v0 = acc[ai][bj][m][0] + bv[bj][0], v1 = acc[ai][bj][m][1] + bv[bj][1];
#pragma unroll
                    for (int j = 0; j < 4; ++j) { v0[j] = fmaxf(v0[j], 0.f); v0[j] *= v0[j]; v1[j] = fmaxf(v1[j], 0.f); v1[j] *= v1[j]; }
                    u32x4 w; w.x = cvt_pk_bf16(v0[0], v0[1]); w.y = cvt_pk_bf16(v0[2], v0[3]); w.z = cvt_pk_bf16(v1[0], v1[1]); w.w = cvt_pk_bf16(v1[2], v1[3]);
                    *(u32x4*)(rowp + bj * HALF) = w; } }
    }
};
struct EpiR2 {
    static constexpr bool PERM = false, AFTER_DRAIN = false;
    float* out; const float* bias;
    __device__ __forceinline__ void operator()(const f32x4 (&acc)[2][2][4][2], const Unit& u, int wr, int wc, int fr, int fq) const {
        const int row0 = u.pm * BM + wr * 64 + fr, col0 = u.pn * BM + wc * 32 + 4 * fq;
        f32x4 bv[2][2];
#pragma unroll
        for (int bj = 0; bj < 2; ++bj)
#pragma unroll
            for (int n = 0; n < 2; ++n) bv[bj][n] = *(const f32x4*)(bias + col0 + bj * HALF + n * 16);
#pragma unroll
        for (int ai = 0; ai < 2; ++ai)
#pragma unroll
            for (int m = 0; m < 4; ++m) { const size_t off = (size_t)(row0 + ai * HALF + m * 16) * D + col0;
#pragma unroll
                for (int bj = 0; bj < 2; ++bj)
#pragma unroll
                    for (int n = 0; n < 2; ++n) { float* p = out + off + bj * HALF + n * 16; const f32x4 xv = *(const f32x4*)p; *(f32x4*)p = xv * ALPHA + acc[ai][bj][m][n] + bv[bj][n]; }
                asm volatile("" ::: "memory"); }
    }
};

template <class Epi, class Sched, bool ALIGN_EPI = true>
__device__ __forceinline__ void gemm_phase(PG8_LAS unsigned char* lds, const Gemm g, const Sched& S, const Epi& E) {
    const int tid = threadIdx.x, wid = __builtin_amdgcn_readfirstlane(tid >> 6), lane = tid & 63, wr = wid >> 2, wc = wid & 3, fr = lane & 15, fq = lane >> 4;
    const int K = g.K, nt = K / BK;
    unsigned voffA[2], voffB[2];
#pragma unroll
    for (int i = 0; i < 2; ++i) { int R, C; stage_rc(tid * 16 + i * 8192, R, C); const int Rb = Epi::PERM ? ((R & ~31) + perm32(R & 31)) : R;
        voffA[i] = (unsigned)(R * g.lda + C) * 2u; voffB[i] = (unsigned)(Rb * g.ldb + C) * 2u; }
    const size_t kstep = (size_t)(BK * 2);
    const size_t hstepA = (size_t)HALF * g.lda * 2, hstepB = (size_t)HALF * g.ldb * 2;
    const size_t tstepA = 2 * hstepA, tstepB = 2 * hstepB;
    const unsigned ldsw = (unsigned)wid * 1024u;
    const int aoff = lds_byte(wr * 64 + fr, fq * 8), boff = lds_byte(wc * 32 + fr, fq * 8);
#define PG8_SA(b, h) (((b) * 2 + (h)) * HTB)
#define PG8_SB(b, h) ((4 + (b) * 2 + (h)) * HTB)
#define PG8_STAGE(bufoff, gbase, voff) do { _Pragma("unroll") for (int _i = 0; _i < 2; ++_i) \
        __builtin_amdgcn_global_load_lds((const unsigned*)((const char*)(gbase) + (voff)[_i]), (PG8_LAS unsigned*)(lds + (bufoff) + ldsw + _i * 8192), 16, 0, 0); } while (0)
#define PG8_LDA(dst, b, h) do { _Pragma("unroll") for (int m = 0; m < 4; ++m) _Pragma("unroll") for (int k = 0; k < 2; ++k) dst[m][k] = *(const PG8_LAS bf16x8*)(lds + PG8_SA(b, h) + aoff + m * 2048 + k * 1024); } while (0)
#define PG8_LDB(dst, b, h) do { _Pragma("unroll") for (int n = 0; n < 2; ++n) _Pragma("unroll") for (int k = 0; k < 2; ++k) dst[n][k] = *(const PG8_LAS bf16x8*)(lds + PG8_SB(b, h) + boff + n * 2048 + k * 1024); } while (0)
#define PG8_MMA(ai, bj, At, Bt) do { __builtin_amdgcn_s_setprio(1); _Pragma("unroll") for (int m = 0; m < 4; ++m) _Pragma("unroll") for (int n = 0; n < 2; ++n) _Pragma("unroll") for (int k = 0; k < 2; ++k) \
        acc[ai][bj][m][n] = __builtin_amdgcn_mfma_f32_16x16x32_bf16(Bt[n][k], At[m][k], acc[ai][bj][m][n], 0, 0, 0); __builtin_amdgcn_s_setprio(0); } while (0)
#define PG8_WAIT_V(n) asm volatile("s_waitcnt vmcnt(" #n ")" ::: "memory")
#define PG8_WAIT_L(n) asm volatile("s_waitcnt lgkmcnt(" #n ")" ::: "memory")
#define PG8_BAR __builtin_amdgcn_s_barrier()
#define PG8_SCHED __builtin_amdgcn_sched_barrier(0)
    Unit cur, nxt; int ui = 0;
    if (!S.next(0, cur)) return;
    f32x4 acc[2][2][4][2];
#pragma unroll
    for (int a = 0; a < 2; ++a)
#pragma unroll
        for (int b = 0; b < 2; ++b)
#pragma unroll
            for (int m = 0; m < 4; ++m)
#pragma unroll
                for (int n = 0; n < 2; ++n) acc[a][b][m][n] = (f32x4){0.f, 0.f, 0.f, 0.f};
    bf16x8 At[4][2], B0[2][2], B1[2][2];
    const char* cA = (const char*)g.A + (size_t)cur.pm * tstepA; const char* cB = (const char*)g.Bt + (size_t)cur.pn * tstepB;
    S.a_ready(cur);
    PG8_STAGE(PG8_SB(0, 0), cB, voffB); PG8_STAGE(PG8_SB(0, 1), cB + hstepB, voffB); PG8_STAGE(PG8_SA(0, 0), cA, voffA); PG8_STAGE(PG8_SA(0, 1), cA + hstepA, voffA);
    if (wr == 1) PG8_BAR;
    PG8_WAIT_V(2); PG8_BAR;
    PG8_STAGE(PG8_SB(1, 0), cB + kstep, voffB); PG8_STAGE(PG8_SA(1, 0), cA + kstep, voffA); PG8_STAGE(PG8_SB(1, 1), cB + hstepB + kstep, voffB);
    PG8_WAIT_V(6); PG8_BAR;
    for (;;) {
        const bool has_next = S.next(ui + 1, nxt);
        const char* nA = has_next ? (const char*)g.A + (size_t)nxt.pm * tstepA : cA; const char* nB = has_next ? (const char*)g.Bt + (size_t)nxt.pn * tstepB : cB;
        for (int t = 0; t < nt; t += 2) {
            const bool last = (t == nt - 2);
            const char* a1 = cA + (size_t)(t + 1) * kstep;
            const char* a2 = last ? nA : cA + (size_t)(t + 2) * kstep; const char* b2 = last ? nB : cB + (size_t)(t + 2) * kstep;
            const char* a3 = a2 + kstep; const char* b3 = b2 + kstep;
            if (last && has_next) S.a_ready(nxt);
            PG8_LDB(B0, 0, 0); PG8_LDB(B1, 0, 1); PG8_SCHED; PG8_LDA(At, 0, 0); PG8_STAGE(PG8_SA(1, 1), a1 + hstepA, voffA);
            PG8_WAIT_V(8); PG8_WAIT_L(0); PG8_BAR; PG8_MMA(0, 0, At, B0); PG8_MMA(0, 1, At, B1); PG8_BAR; PG8_SCHED;
            PG8_LDA(At, 0, 1); PG8_STAGE(PG8_SB(0, 0), b2, voffB); PG8_STAGE(PG8_SB(0, 1), b2 + hstepB, voffB); PG8_STAGE(PG8_SA(0, 0), a2, voffA);
            PG8_WAIT_V(8); PG8_WAIT_L(0); PG8_BAR; PG8_MMA(1, 0, At, B0); PG8_MMA(1, 1, At, B1); PG8_BAR; PG8_SCHED;
            PG8_LDB(B0, 1, 0); PG8_LDB(B1, 1, 1); PG8_SCHED; PG8_LDA(At, 1, 0); PG8_STAGE(PG8_SA(0, 1), a2 + hstepA, voffA);
            PG8_WAIT_V(8); PG8_WAIT_L(0); PG8_BAR; PG8_MMA(0, 0, At, B0); PG8_MMA(0, 1, At, B1); PG8_BAR; PG8_SCHED;
            PG8_LDA(At, 1, 1); PG8_STAGE(PG8_SB(1, 0), b3, voffB); PG8_STAGE(PG8_SB(1, 1), b3 + hstepB, voffB); PG8_STAGE(PG8_SA(1, 0), a3, voffA);
            PG8_WAIT_V(8); PG8_WAIT_L(0); PG8_BAR; PG8_MMA(1, 0, At, B0); PG8_MMA(1, 1, At, B1); PG8_BAR; PG8_SCHED;
        }
        if constexpr (ALIGN_EPI) { if (wr == 0) PG8_BAR; }
        E(acc, cur, wr, wc, fr, fq); S.done(cur);
        if (!has_next) break;
#pragma unroll
        for (int a = 0; a < 2; ++a)
#pragma unroll
            for (int b = 0; b < 2; ++b)
#pragma unroll
                for (int m = 0; m < 4; ++m)
#pragma unroll
                    for (int n = 0; n < 2; ++n) acc[a][b][m][n] = (f32x4){0.f, 0.f, 0.f, 0.f};
        cur = nxt; cA = nA; cB = nB; ++ui;
        if constexpr (ALIGN_EPI) { if (wr == 1) PG8_BAR; }
    }
    PG8_WAIT_V(0);
    if constexpr (!ALIGN_EPI) { if (wr == 0) PG8_BAR; }
    PG8_BAR;
#undef PG8_SA
#undef PG8_SB
#undef PG8_STAGE
#undef PG8_LDA
#undef PG8_LDB
#undef PG8_MMA
#undef PG8_WAIT_V
#undef PG8_WAIT_L
#undef PG8_BAR
#undef PG8_SCHED
}
}

namespace scan {
#define SLAS __attribute__((address_space(3)))
typedef short bf16x8 __attribute__((ext_vector_type(8)));
typedef float f32x16 __attribute__((ext_vector_type(16)));
typedef float f32x4 __attribute__((ext_vector_type(4)));
typedef unsigned u32x4 __attribute__((ext_vector_type(4)));
typedef unsigned u32x2 __attribute__((ext_vector_type(2)));
typedef __bf16 bf16x2v __attribute__((ext_vector_type(2)));
typedef float f32x2v __attribute__((ext_vector_type(2)));
#define MFMA32(a, b, c) __builtin_amdgcn_mfma_f32_32x32x16_bf16((a), (b), (c), 0, 0, 0)
__device__ __forceinline__ unsigned pk2c(float a, float b) { f32x2v f = {a, b}; bf16x2v r = __builtin_convertvector(f, bf16x2v); return __builtin_bit_cast(unsigned, r); }
__device__ __forceinline__ bf16x8 pack8(float a0, float a1, float a2, float a3, float a4, float a5, float a6, float a7) {
    u32x4 p; p.x = pk2c(a0, a1); p.y = pk2c(a2, a3); p.z = pk2c(a4, a5); p.w = pk2c(a6, a7); return __builtin_bit_cast(bf16x8, p); }
__device__ __forceinline__ int crow(int i, int hf) { return (i & 3) + 8 * (i >> 2) + 4 * hf; }
__device__ __forceinline__ float sigm(float x) { return __builtin_amdgcn_rcpf(1.f + __expf(-x)); }
__device__ __forceinline__ float gelu_t(float x) { const float u = 1.5957691216057308f * (x + 0.044715f * x * x * x); return x * sigm(u); }

constexpr int RG_NC = 32, RG_L = SEQ / RG_NC, RG_STEPS = RG_L / 16, RG_NS = NB * RG_NC;
constexpr int S5_NC = 256, S5_L = SEQ / S5_NC, S5_NS = NB * S5_NC, S5_UNITS = (S5_NS / 32) * NG;
constexpr size_t WS_RGP = WS_X1B, WS_RGS = WS_RGP + 512 * 1024, WS_RGH = WS_RGS + 512 * 1024;
constexpr size_t WS_S5S = WS_X1B + 2 * MiB, WS_S5H = WS_S5S + 16 * MiB;
static_assert(WS_S5H + 16 * MiB <= WS_Z, "scan scratch fits the X1B region");
constexpr int RG_HB_LDS = 51200;

__device__ __forceinline__ void rglru_pack_weights(const float* __restrict__ wa, const float* __restrict__ wx, bf16_t* RGW, int idx) {
    const int lane = idx & 63, ks = (idx >> 6) & 7, gate = (idx >> 9) & 1, w4 = (idx >> 10) & 3, hd = idx >> 12;
    const float* p = (gate ? wx : wa) + (size_t)hd * HD * HD + (size_t)(16 * ks + 8 * (lane >> 5)) * HD + w4 * 32 + (lane & 31);
    ((bf16x8*)RGW)[idx] = pack8(p[0], p[HD], p[2 * HD], p[3 * HD], p[4 * HD], p[5 * HD], p[6 * HD], p[7 * HD]);
}
template <bool PASS_B>
__device__ __forceinline__ void rglru_pass(SLAS unsigned char* lds, bf16_t* Z, const float* __restrict__ conv_w, const float* __restrict__ conv_b, const bf16_t* __restrict__ RGW, const float* __restrict__ ba,
                                           const float* __restrict__ bxp, const float* __restrict__ lam, float* RGP, float* RGS, const float* RGH, int bx, int G) {
    const int tid = threadIdx.x, lane = tid & 63, wave = __builtin_amdgcn_readfirstlane(tid >> 6), hb = wave >> 2, w4 = wave & 3, t4 = tid & 255;
    const int col = lane & 31, hf = lane >> 5;
    SLAS unsigned char* base = lds + hb * RG_HB_LDS;
    for (int ub = bx; ub < 256; ub += G) {
        const int unit = 2 * ub + hb, hd = unit & 15, sp = unit >> 4;
        const int cs = t4 >> 7, cch = t4 & 127, s_conv = 2 * sp + cs, chc = hd * HD + cch;
        const int cconv = s_conv % RG_NC;
        const bf16_t* zx = Z + (size_t)((s_conv / RG_NC) * SEQ + cconv * RG_L) * DIN + O_XR + chc;
        const float cw0 = conv_w[0 * D + chc], cw1 = conv_w[1 * D + chc], cw2 = conv_w[2 * D + chc], cw3 = conv_w[3 * D + chc], cb = conv_b[chc];
        float x1 = 0.f, x2 = 0.f, x3 = 0.f;
        if (cconv > 0) { x1 = bf2f(zx[-(ptrdiff_t)DIN]); x2 = bf2f(zx[-2 * (ptrdiff_t)DIN]); x3 = bf2f(zx[-3 * (ptrdiff_t)DIN]); }
        const int s_scan = 2 * sp + hf, ch = hd * HD + w4 * 32 + col;
        bf16_t* zg = Z + (size_t)((s_scan / RG_NC) * SEQ + (s_scan % RG_NC) * RG_L) * DIN + O_GR + ch;
        const float bav = ba[ch], bxv = bxp[ch], lac = -8.f * log1pf(expf(-lam[ch]));
        bf16x8 Br[8], Bi[8];
        {
            const bf16x8* wf = (const bf16x8*)RGW + (size_t)((hd * 4 + w4) * 2) * 8 * 64 + lane;
#pragma unroll
            for (int ks = 0; ks < 8; ++ks) { Br[ks] = wf[ks * 64]; Bi[ks] = wf[(8 + ks) * 64]; }
        }
        float h = PASS_B ? RGH[(size_t)s_scan * D + ch] : 0.f, P = 1.f;
        bf16_t cur[16];
#pragma unroll
        for (int k = 0; k < 16; ++k) cur[k] = zx[(size_t)k * DIN];
        for (int step = 0; step < RG_STEPS; ++step) {
            const int pb = step & 1;
            SLAS bf16_t* At = (SLAS bf16_t*)(base + pb * 8704); SLAS float* Ft = (SLAS float*)(base + 17408 + pb * 16896);
            bf16_t gg[16];
            if (PASS_B) {
#pragma unroll
                for (int i = 0; i < 16; ++i) gg[i] = zg[(size_t)(16 * step + i) * DIN];
            }
#pragma unroll
            for (int k = 0; k < 16; ++k) {
                const float x0 = bf2f(cur[k]);
                const float xc = cw0 * x3 + cw1 * x2 + cw2 * x1 + cw3 * x0 + cb;
                x3 = x2; x2 = x1; x1 = x0;
                const int row = (k & 3) + 8 * (k >> 2) + 4 * cs;
                At[row * 136 + cch] = (bf16_t)(pk2c(xc, 0.f) & 0xffffu); Ft[row * 132 + cch] = xc;
            }
            if (step + 1 < RG_STEPS) {
#pragma unroll
                for (int k = 0; k < 16; ++k) cur[k] = zx[(size_t)(16 * (step + 1) + k) * DIN];
            }
            __syncthreads();
            f32x16 accR, accI;
#pragma unroll
            for (int i = 0; i < 16; ++i) { accR[i] = 0.f; accI[i] = 0.f; }
#pragma unroll
            for (int ks = 0; ks < 8; ++ks) { const bf16x8 af = *(const SLAS bf16x8*)(At + col * 136 + 16 * ks + 8 * hf);
                accR = MFMA32(af, Br[ks], accR); accI = MFMA32(af, Bi[ks], accI); }
#pragma unroll
            for (int i = 0; i < 16; ++i) {
                const float xc = Ft[crow(i, hf) * 132 + w4 * 32 + col];
                const float r = sigm(accR[i] + bav), ig = sigm(accI[i] + bxv);
                const float la = r * lac, av = __expf(la), x = 2.f * la;
                const float m2 = -x * (1.f + x * (0.5f + x * (0.16666667f + x * (0.041666668f + x * (0.008333334f + x * 0.0013888889f)))));
                const float bb = __builtin_amdgcn_sqrtf(m2) * (ig * xc);
                h = av * h + bb;
                if (PASS_B) zg[(size_t)(16 * step + i) * DIN] = (bf16_t)(pk2c(h * bf2f(gg[i]), 0.f) & 0xffffu);
                else P *= av;
                if ((i & 3) == 3) __builtin_amdgcn_sched_barrier(0);
            }
        }
        if (!PASS_B) { RGP[(size_t)s_scan * D + ch] = P; RGS[(size_t)s_scan * D + ch] = h; }
        __syncthreads();
    }
}
__device__ __forceinline__ void rglru_carry(const float* RGP, const float* RGS, float* RGH, int idx) {
    const int b = idx / D, ch = idx % D; float H = 0.f;
#pragma unroll 8
    for (int c = 0; c < RG_NC; ++c) { const size_t o = (size_t)(b * RG_NC + c) * D + ch; RGH[o] = H; H = RGP[o] * H + RGS[o]; }
}

__device__ __forceinline__ size_t s5_idx(int g, int T, int row, int s) { return ((size_t)(g * 128 + (T >> 1) * 64 + (T & 1) * 32 + row)) * S5_NS + s; }
template <bool PASS_B>
__device__ __forceinline__ void s5_pass(bf16_t* Z, const float2* __restrict__ lamtab, const float* __restrict__ bbr, const float* __restrict__ bbi, const float* __restrict__ c_re, const float* __restrict__ c_im,
                                        const float* __restrict__ dd, float* S5S, const float* S5H, SLAS f32x2v* ltab  , int gw, int NGW, int lane) {
    const int col = lane & 31, hf = lane >> 5;
    for (int unit = gw; unit < S5_UNITS; unit += NGW) {
        const int g = unit & (NG - 1), sset = unit / NG;
        const int s = sset * 32 + col, b = s / S5_NC, c = s % S5_NC;
        bf16_t* zu = Z + ((size_t)b * SEQ + (size_t)c * S5_L) * DIN + O_U + g * GS;
        bf16x8 Ab[4];
#pragma unroll
        for (int T = 0; T < 4; ++T) { const float* src = ((T >> 1) ? bbi : bbr) + (size_t)(g * NP + 32 * (T & 1) + col) * GS + 8 * hf;
            Ab[T] = pack8(src[0], src[1], src[2], src[3], src[4], src[5], src[6], src[7]); }
        { const int e_hf = lane >> 5, e_tp = (lane >> 4) & 1, e_i = lane & 15; const float2 lv = lamtab[g * NP + 32 * e_tp + crow(e_i, e_hf)]; f32x2v lw = {lv.x, lv.y}; ltab[lane] = lw; }
        f32x16 h[4];
#pragma unroll
        for (int T = 0; T < 4; ++T)
#pragma unroll
            for (int i = 0; i < 16; ++i) h[T][i] = PASS_B ? S5H[s5_idx(g, T, crow(i, hf), s)] : 0.f;
        bf16x8 Ac[4][2], Adh, Adl;
        if (PASS_B) {
            const int hp = col & 15; const bool live = col < 16;
#pragma unroll
            for (int T = 0; T < 4; ++T)
#pragma unroll
                for (int sk = 0; sk < 2; ++sk) { float v[8];
#pragma unroll
                    for (int j = 0; j < 8; ++j) { const int p = 32 * (T & 1) + 16 * sk + 8 * (j >> 2) + 4 * hf + (j & 3);
                        const float cv = (T < 2) ? c_re[(size_t)(g * GS + hp) * NP + p] : -c_im[(size_t)(g * GS + hp) * NP + p]; v[j] = live ? cv : 0.f; }
                    Ac[T][sk] = pack8(v[0], v[1], v[2], v[3], v[4], v[5], v[6], v[7]); }
            const float dv = dd[g * GS + hp]; const float dhi = __uint_as_float(pk2c(dv, 0.f) << 16), dlo = dv - dhi;
            float vh[8], vl[8];
#pragma unroll
            for (int j = 0; j < 8; ++j) { const bool on = live && (hp == 8 * hf + j); vh[j] = on ? dhi : 0.f; vl[j] = on ? dlo : 0.f; }
            Adh = pack8(vh[0], vh[1], vh[2], vh[3], vh[4], vh[5], vh[6], vh[7]); Adl = pack8(vl[0], vl[1], vl[2], vl[3], vl[4], vl[5], vl[6], vl[7]);
        }
        bf16x8 u = *(const bf16x8*)(zu + 8 * hf);
        for (int step = 0; step < S5_L; ++step) {
            bf16x8 un = u;
            if (step + 1 < S5_L) un = *(const bf16x8*)(zu + (size_t)(step + 1) * DIN + 8 * hf);
            asm volatile("" ::: "memory");
#pragma unroll
            for (int tp = 0; tp < 2; ++tp) { f32x16 tr, ti;
#pragma unroll
                for (int i = 0; i < 16; i += 2) { const f32x4 l2 = *(const SLAS f32x4*)(ltab + (hf * 2 + tp) * 16 + i);
                    tr[i] = l2[0] * h[tp][i] - l2[1] * h[tp + 2][i]; ti[i] = l2[0] * h[tp + 2][i] + l2[1] * h[tp][i];
                    tr[i + 1] = l2[2] * h[tp][i + 1] - l2[3] * h[tp + 2][i + 1]; ti[i + 1] = l2[2] * h[tp + 2][i + 1] + l2[3] * h[tp][i + 1]; }
                h[tp] = MFMA32(Ab[tp], u, tr); h[tp + 2] = MFMA32(Ab[tp + 2], u, ti);
                __builtin_amdgcn_sched_barrier(0); }
            if (PASS_B) {
                f32x16 y;
#pragma unroll
                for (int i = 0; i < 16; ++i) y[i] = 0.f;
                y = MFMA32(Adh, u, y); y = MFMA32(Adl, u, y);
#pragma unroll
                for (int T = 0; T < 4; ++T)
#pragma unroll
                    for (int sk = 0; sk < 2; ++sk) { const bf16x8 xb = pack8(h[T][8 * sk], h[T][8 * sk + 1], h[T][8 * sk + 2], h[T][8 * sk + 3], h[T][8 * sk + 4], h[T][8 * sk + 5], h[T][8 * sk + 6], h[T][8 * sk + 7]);
                        y = MFMA32(Ac[T][sk], xb, y); }
                u32x2 o0, o1; o0.x = pk2c(gelu_t(y[0]), gelu_t(y[1])); o0.y = pk2c(gelu_t(y[2]), gelu_t(y[3])); o1.x = pk2c(gelu_t(y[4]), gelu_t(y[5])); o1.y = pk2c(gelu_t(y[6]), gelu_t(y[7]));
                bf16_t* zo = zu + (size_t)step * DIN + 4 * hf;
                *(u32x2*)zo = o0; *(u32x2*)(zo + 8) = o1;
            }
            u = un;
        }
        if (!PASS_B) {
#pragma unroll
            for (int T = 0; T < 4; ++T)
#pragma unroll
                for (int i = 0; i < 16; ++i) S5S[s5_idx(g, T, crow(i, hf), s)] = h[T][i];
        }
    }
}
__device__ __forceinline__ void s5_carry(const float2* __restrict__ lamtab, const float* S5S, float* S5H, int idx) {
    const int b = idx / (NG * NP), gp = idx % (NG * NP), g = gp / NP, p = gp % NP;
    float2 L = lamtab[gp];
#pragma unroll
    for (int k = 0; k < 5; ++k) { const float nr = L.x * L.x - L.y * L.y, ni = 2.f * L.x * L.y; L.x = nr; L.y = ni; }
    static_assert(S5_L == 32, "lambda^L by 5 squarings");
    const size_t ore = ((size_t)(g * 128 + p)) * S5_NS + (size_t)b * S5_NC, oim = ore + (size_t)64 * S5_NS;
    const f32x4* sre = (const f32x4*)(S5S + ore); const f32x4* sim = (const f32x4*)(S5S + oim);
    f32x4* hre = (f32x4*)(S5H + ore); f32x4* him = (f32x4*)(S5H + oim);
    float Hr = 0.f, Hi = 0.f;
#pragma unroll 4
    for (int c4 = 0; c4 < S5_NC / 4; ++c4) {
        const f32x4 vr = sre[c4], vi = sim[c4]; f32x4 orr, oi;
#pragma unroll
        for (int j = 0; j < 4; ++j) { orr[j] = Hr; oi[j] = Hi; const float nr = L.x * Hr - L.y * Hi + vr[j], ni = L.x * Hi + L.y * Hr + vi[j]; Hr = nr; Hi = ni; }
        hre[c4] = orr; him[c4] = oi;
    }
}
}

namespace cg = cooperative_groups;
#define LAS __attribute__((address_space(3)))
constexpr int NWAVES = 8, NTHREADS = NWAVES * 64;
constexpr int LDS_BYTES = 147456;
typedef float f32x4 __attribute__((ext_vector_type(4)));
typedef unsigned u32x4 __attribute__((ext_vector_type(4)));
typedef unsigned u32x2 __attribute__((ext_vector_type(2)));
struct Args { const float* in[N_IN]; float* out; unsigned char* ws; int ph_lo, ph_hi; };
static_assert(sizeof(Args) == (N_IN + 2) * 8 + 8, "Args has no padding");

__device__ __forceinline__ unsigned pk2(float lo, float hi) { return pg8::cvt_pk_bf16(lo, hi); }
__device__ __forceinline__ int rowmap(int mode, int n) { return mode == 0 ? n : ((n >> 7) * 256 + (mode == 2 ? 128 : 0) + (n & 127)); }
__device__ __forceinline__ void p0_transpose_item(const float* __restrict__ W, int K, int N, bf16_t* __restrict__ WT, int mode, LAS float* scr, int item, int lane) {
    const int nblk = N / 32, kb = item / nblk, nb = item % nblk, k0 = 64 * kb, n0 = 32 * nb;
#pragma unroll 8
    for (int i = 0; i < 32; ++i) { const int kk = 2 * i + (lane >> 5); scr[kk * 33 + (lane & 31)] = W[(size_t)(k0 + kk) * N + n0 + (lane & 31)]; }
    asm volatile("s_waitcnt lgkmcnt(0)" ::: "memory");
    const int c = lane & 7, rbase = rowmap(mode, n0);
#pragma unroll
    for (int j = 0; j < 4; ++j) { const int n = (lane >> 3) + 8 * j; const LAS float* s = scr + (8 * c) * 33 + n;
        u32x4 o; o.x = pk2(s[0 * 33], s[1 * 33]); o.y = pk2(s[2 * 33], s[3 * 33]); o.z = pk2(s[4 * 33], s[5 * 33]); o.w = pk2(s[6 * 33], s[7 * 33]);
        *(u32x4*)(WT + (size_t)(rbase + n) * K + k0 + 8 * c) = o; }
    asm volatile("s_waitcnt lgkmcnt(0)" ::: "memory");
}
__device__ __forceinline__ float wave_sum(float v) {
#pragma unroll
    for (int o = 1; o < 64; o <<= 1) v += __shfl_xor(v, o);
    return v;
}
__device__ __forceinline__ void ln_row(float* xrow, const float* __restrict__ g, const float* __restrict__ bt, bf16_t* orow, int lane) {
    f32x4* xr = (f32x4*)xrow + lane;
    f32x4 v[8]; float s = 0.f;
#pragma unroll
    for (int j = 0; j < 8; ++j) { v[j] = xr[64 * j]; s += (v[j].x + v[j].y) + (v[j].z + v[j].w); }
    const float mean = wave_sum(s) * (1.f / D); float s2 = 0.f;
#pragma unroll
    for (int j = 0; j < 8; ++j) { v[j] = v[j] - mean; s2 += (v[j].x * v[j].x + v[j].y * v[j].y) + (v[j].z * v[j].z + v[j].w * v[j].w); }
    const float rstd = rsqrtf(wave_sum(s2) * (1.f / D) + LN_EPS);
#pragma unroll
    for (int j = 0; j < 8; ++j) { const f32x4 gv = *((const f32x4*)g + lane + 64 * j), bv = *((const f32x4*)bt + lane + 64 * j);
        const f32x4 y = v[j] * rstd * gv + bv; xr[64 * j] = y;
        if (orow) { u32x2 w; w.x = pk2(y.x, y.y); w.y = pk2(y.z, y.w); *((u32x2*)orow + lane + 64 * j) = w; } }
}

__global__ void __launch_bounds__(NTHREADS, 2) mk_fwd(Args a) {
    extern __shared__ __attribute__((aligned(16))) unsigned char lds_raw[];
    LAS unsigned char* lds = (LAS unsigned char*)lds_raw;
    cg::grid_group grid = cg::this_grid();
    const int tid = threadIdx.x, lane = tid & 63, wave = __builtin_amdgcn_readfirstlane(tid >> 6);
    const int G = gridDim.x, bx = blockIdx.x;
    const int gw = bx * NWAVES + wave, NGW = G * NWAVES;
    unsigned char* ws = a.ws;
    bf16_t *Wt_in = (bf16_t*)(ws + WS_WIN), *Wt_a = (bf16_t*)(ws + WS_WA), *Wt_glu = (bf16_t*)(ws + WS_WGLU), *Wt_out = (bf16_t*)(ws + WS_WOUT), *Wt_up = (bf16_t*)(ws + WS_WUP), *Wt_down = (bf16_t*)(ws + WS_WDOWN);
    bf16_t *X1B = (bf16_t*)(ws + WS_X1B), *Z = (bf16_t*)(ws + WS_Z), *HMID = (bf16_t*)(ws + WS_Z), *XB = (bf16_t*)a.out;
    const int lo = a.ph_lo, hi = a.ph_hi;
#define IN(k) (lo <= (k) && (k) < hi)
#define SEAM(k) do { if (IN(k) && IN((k) + 1)) grid.sync(); } while (0)

    if (IN(0)) {
        LAS float* scr = (LAS float*)(lds + wave * 16384);
        constexpr int I_IN = (D / 64) * (DIN / 32), I_A = (D / 64) * (D / 32), I_GL = (DSSM / 64) * (D / 32), I_UP = (D / 64) * (DFF / 32), I_DN = (DFF / 64) * (D / 32);
        constexpr int NITEMS = I_IN + 2 * I_A + 2 * I_GL + I_UP + I_DN;
        for (int it = gw; it < NITEMS; it += NGW) {
            int r = it;
            if (r < I_IN) { p0_transpose_item(a.in[I_WIN], D, DIN, Wt_in, 0, scr, r, lane); continue; } r -= I_IN;
            if (r < I_A) { p0_transpose_item(a.in[I_WAOUT], D, D, Wt_a, 0, scr, r, lane); continue; } r -= I_A;
            if (r < I_GL) { p0_transpose_item(a.in[I_GLUW], DSSM, D, Wt_glu, 1, scr, r, lane); continue; } r -= I_GL;
            if (r < I_GL) { p0_transpose_item(a.in[I_GLUV], DSSM, D, Wt_glu, 2, scr, r, lane); continue; } r -= I_GL;
            if (r < I_A) { p0_transpose_item(a.in[I_WOUT], D, D, Wt_out, 0, scr, r, lane); continue; } r -= I_A;
            if (r < I_UP) { p0_transpose_item(a.in[I_WUP], D, DFF, Wt_up, 0, scr, r, lane); continue; } r -= I_UP;
            p0_transpose_item(a.in[I_WDOWN], DFF, D, Wt_down, 0, scr, r, lane);
        }
        {
            const float* x = a.in[I_X]; const size_t n8 = (size_t)M * D / 8;
            for (size_t i = (size_t)bx * NTHREADS + tid; i < n8; i += (size_t)G * NTHREADS) {
                const f32x4 v0 = *((const f32x4*)x + 2 * i), v1 = *((const f32x4*)x + 2 * i + 1);
                u32x4 w; w.x = pk2(v0.x, v0.y); w.y = pk2(v0.z, v0.w); w.z = pk2(v1.x, v1.y); w.w = pk2(v1.z, v1.w);
                *((u32x4*)XB + i) = w; }
        }
        for (int idx = bx * NTHREADS + tid; idx < 16 * 4 * 2 * 8 * 64; idx += G * NTHREADS) scan::rglru_pack_weights(a.in[I_WA], a.in[I_WX], (bf16_t*)(ws + WS_RGW), idx);
        {
            const int idx = bx * NTHREADS + tid;
            if (idx < NG * NP) {
                float2* lam = (float2*)(ws + WS_S5LAM); float* bbr = (float*)(ws + WS_S5BBR); float* bbi = (float*)(ws + WS_S5BBI);
                const int g = idx / NP;
                const double dt = exp((double)a.in[I_LOGDT][g]);
                const double lr = fmin((double)a.in[I_ARE][idx], -1e-4), li = (double)a.in[I_AIM][idx];
                const double mag = exp(lr * dt), lbr = mag * cos(li * dt), lbi = mag * sin(li * dt);
                const double zr = lbr - 1.0, zi = lbi, den = lr * lr + li * li;
                const double fr = (zr * lr + zi * li) / den, fi = (zi * lr - zr * li) / den;
                lam[idx] = make_float2((float)lbr, (float)lbi);
                for (int h = 0; h < GS; ++h) { const double br = a.in[I_BRE][idx * GS + h], bi = a.in[I_BIM][idx * GS + h];
                    bbr[idx * GS + h] = (float)(fr * br - fi * bi); bbi[idx * GS + h] = (float)(fr * bi + fi * br); }
            }
        }
        __syncthreads();
    }
    SEAM(0);
    if (IN(1)) { pg8::Gemm g{XB, D, Wt_in, D, M, DIN, D}; pg8::StaticOrder S; S.init(M, DIN, G, bx); pg8::gemm_phase(lds, g, S, pg8::EpiZ{Z}); }
    SEAM(1);
    {
        const float2* lamtab = (const float2*)(ws + WS_S5LAM); const float* bbr = (const float*)(ws + WS_S5BBR); const float* bbi = (const float*)(ws + WS_S5BBI);
        const bf16_t* RGW = (const bf16_t*)(ws + WS_RGW); float *RGP = (float*)(ws + scan::WS_RGP), *RGS = (float*)(ws + scan::WS_RGS), *RGH = (float*)(ws + scan::WS_RGH), *S5S = (float*)(ws + scan::WS_S5S), *S5H = (float*)(ws + scan::WS_S5H);
        if (IN(2)) {
            scan::rglru_pass<false>(lds, Z, a.in[I_CONVW], a.in[I_CONVB], RGW, a.in[I_BA], a.in[I_BX], a.in[I_LAM], RGP, RGS, RGH, bx, G);
            scan::s5_pass<false>(Z, lamtab, bbr, bbi, a.in[I_CRE], a.in[I_CIM], a.in[I_SD], S5S, S5H, (LAS scan::f32x2v*)(lds + 114688 + wave * 512), gw, NGW, lane);
        }
        SEAM(2);
        if (IN(3)) {
            if (tid < 48) for (int idx = bx * 48 + tid; idx < NB * NG * NP + NB * D; idx += G * 48) {
                if (idx < NB * NG * NP) scan::s5_carry(lamtab, S5S, S5H, idx); else scan::rglru_carry(RGP, RGS, RGH, idx - NB * NG * NP); }
        }
        SEAM(3);
        if (IN(4)) {
            scan::rglru_pass<true>(lds, Z, a.in[I_CONVW], a.in[I_CONVB], RGW, a.in[I_BA], a.in[I_BX], a.in[I_LAM], RGP, RGS, RGH, bx, G);
            scan::s5_pass<true>(Z, lamtab, bbr, bbi, a.in[I_CRE], a.in[I_CIM], a.in[I_SD], S5S, S5H, (LAS scan::f32x2v*)(lds + 114688 + wave * 512), gw, NGW, lane);
        }
        SEAM(4);
    }
    if (IN(5)) { pg8::Gemm g{Z + O_U, DIN, Wt_glu, DSSM, M, 2 * D, DSSM}; pg8::StaticOrder S; S.init(M, 2 * D, G, bx); pg8::gemm_phase(lds, g, S, pg8::EpiGlu{Z}); }
    SEAM(5);
    if (IN(6)) { pg8::Gemm g{Z + O_GR, DIN, Wt_a, D, M, D, D}; pg8::StaticOrder S; S.init(M, D, G, bx); pg8::gemm_phase(lds, g, S, pg8::EpiMix{Z}); }
    SEAM(6);
    if (IN(7)) { pg8::Gemm g{Z + O_GA, DIN, Wt_out, D, M, D, D}; pg8::StaticOrder S; S.init(M, D, G, bx); pg8::gemm_phase(lds, g, S, pg8::EpiR1{a.in[I_X], a.out}); }
    SEAM(7);
    if (IN(8)) { for (int m = gw; m < M; m += NGW) ln_row(a.out + (size_t)m * D, a.in[I_LN1G], a.in[I_LN1B], X1B + (size_t)m * D, lane); }
    SEAM(8);
    if (IN(9)) { pg8::Gemm g{X1B, D, Wt_up, D, M, DFF, D}; pg8::StaticOrder S; S.init(M, DFF, G, bx); pg8::gemm_phase(lds, g, S, pg8::EpiUp{HMID, a.in[I_BUP]}); }
    SEAM(9);
    if (IN(10)) { pg8::Gemm g{HMID, DFF, Wt_down, DFF, M, D, DFF}; pg8::StaticOrder S; S.init(M, D, G, bx); pg8::gemm_phase(lds, g, S, pg8::EpiR2{a.out, a.in[I_BDOWN]}); }
    SEAM(10);
    if (IN(11)) { for (int m = gw; m < M; m += NGW) ln_row(a.out + (size_t)m * D, a.in[I_LN2G], a.in[I_LN2B], nullptr, lane); }
#undef IN
#undef SEAM
}

#ifndef MK_SCAN_NAIVE
#define MK_SCAN_NAIVE 0
#endif
static hipError_t launch_mk(Args& a, int lo, int hi, int grid, hipStream_t stream) {
    a.ph_lo = lo; a.ph_hi = hi; void* args[] = {&a};
    return hipLaunchCooperativeKernel((const void*)mk_fwd, dim3(grid), dim3(NTHREADS), args, LDS_BYTES, stream);
}
extern "C" void kernel_launch(void* const* d_in, const int* in_sizes, int n_in, void* d_out, int out_size, void* d_ws, size_t ws_size, hipStream_t stream) {
    static int grid = 0;
    if (grid == 0) {
        if (n_in != N_IN || out_size != M * D || ws_size < WS_END) { fprintf(stderr, "kernel_launch: unexpected shapes (n_in %d out %d ws %zu)\n", n_in, out_size, ws_size); grid = -1; return; }
        int dev = 0, cus = 0, per_cu = 0;
        if (hipGetDevice(&dev) != hipSuccess || hipDeviceGetAttribute(&cus, hipDeviceAttributeMultiprocessorCount, dev) != hipSuccess) { grid = -1; return; }
        if (hipFuncSetAttribute((const void*)mk_fwd, hipFuncAttributeMaxDynamicSharedMemorySize, LDS_BYTES) != hipSuccess) { fprintf(stderr, "kernel_launch: hipFuncSetAttribute failed\n"); grid = -1; return; }
        if (hipOccupancyMaxActiveBlocksPerMultiprocessor(&per_cu, (const void*)mk_fwd, NTHREADS, LDS_BYTES) != hipSuccess || per_cu < 1) { fprintf(stderr, "kernel_launch: occupancy query says %d\n", per_cu); grid = -1; return; }
        grid = cus;
#if MK_SCAN_NAIVE
        (void)hipFuncSetAttribute((const void*)nv::k_rglru, hipFuncAttributeMaxDynamicSharedMemorySize, (2 * HD * HD + HD) * 4);
#endif
    }
    if (grid < 0) return;
    Args a{};
    for (int i = 0; i < N_IN; ++i) a.in[i] = (const float*)d_in[i];
    a.out = (float*)d_out; a.ws = (unsigned char*)d_ws;
    hipError_t e;
#if MK_SCAN_NAIVE
    unsigned char* ws = (unsigned char*)d_ws; bf16_t* Z = (bf16_t*)(ws + WS_Z);
    e = launch_mk(a, 0, 2, grid, stream);
    nv::k_rglru<<<NB * HEADS, 128, (2 * HD * HD + HD) * 4, stream>>>(Z, a.in[I_CONVW], a.in[I_CONVB], a.in[I_WA], a.in[I_BA], a.in[I_WX], a.in[I_BX], a.in[I_LAM]);
    nv::k_s5<<<NB * NG, 64, 0, stream>>>(Z, (const float2*)(ws + WS_S5LAM), (const float*)(ws + WS_S5BBR), (const float*)(ws + WS_S5BBI), a.in[I_CRE], a.in[I_CIM], a.in[I_SD]);
    if (e == hipSuccess) e = launch_mk(a, 5, 12, grid, stream);
#else
    e = launch_mk(a, 0, 12, grid, stream);
#endif
    if (e != hipSuccess) fprintf(stderr, "kernel_launch: cooperative launch failed: %s (grid %d)\n", hipGetErrorString(e), grid);
}
```

```cpp
#include <hip/hip_runtime.h>
#include <hip/hip_cooperative_groups.h>
#include <cstdio>
#include <cstdint>

typedef unsigned short bf16_t;
constexpr int NB = 2, SEQ = 8192, M = NB * SEQ, D = 2048, HEADS = 16, HD = 128, DSSM = 1024, NG = 64, GS = 16, NP = 64, DFF = 8192, DIN = 9216;
constexpr int O_XR = 0, O_GR = 2048, O_U = 4096, O_GA = 5120, O_GB = 7168;
constexpr float ALPHA = 1.189207115002721f;
constexpr float LN_EPS = 1e-5f;
enum { I_X = 0, I_WIN, I_CONVW, I_CONVB, I_WA, I_BA, I_WX, I_BX, I_LAM, I_WAOUT, I_ARE, I_AIM, I_LOGDT, I_BRE, I_BIM, I_CRE, I_CIM, I_SD, I_GLUW, I_GLUV, I_WOUT,
       I_LN1G, I_LN1B, I_WUP, I_BUP, I_WDOWN, I_BDOWN, I_LN2G, I_LN2B, N_IN };

constexpr size_t MiB = 1u << 20;
constexpr size_t WS_CTL = 0;
constexpr size_t WS_S5LAM = 1 * MiB;
constexpr size_t WS_S5BBR = WS_S5LAM + 64 * 1024;
constexpr size_t WS_S5BBI = WS_S5BBR + 256 * 1024;
constexpr size_t WS_WIN = 2 * MiB;
constexpr size_t WS_WA = WS_WIN + 36 * MiB;
constexpr size_t WS_WGLU = WS_WA + 8 * MiB;
constexpr size_t WS_WOUT = WS_WGLU + 8 * MiB;
constexpr size_t WS_WUP = WS_WOUT + 8 * MiB;
constexpr size_t WS_WDOWN = WS_WUP + 32 * MiB;
constexpr size_t WS_X1B = WS_WDOWN + 32 * MiB;
constexpr size_t WS_Z = WS_X1B + 64 * MiB;
constexpr size_t WS_RGW = WS_Z + 288 * MiB;
constexpr size_t WS_END = WS_RGW + 1 * MiB;

__device__ __forceinline__ bf16_t f2bf(float f) { unsigned u = __float_as_uint(f); u += 0x7fffu + ((u >> 16) & 1u); return (bf16_t)(u >> 16); }
__device__ __forceinline__ float bf2f(bf16_t b) { return __uint_as_float(((unsigned)b) << 16); }
__device__ __forceinline__ float sigmoid_f(float x) { return 1.f / (1.f + __expf(-x)); }
__device__ __forceinline__ float gelu_tanh(float x) { const float u = 1.5957691216057308f * (x + 0.044715f * x * x * x); return x * sigmoid_f(u); }

namespace nv {
__device__ __forceinline__ int rowmap(int mode, int n) { return mode == 0 ? n : ((n >> 7) * 256 + (mode == 2 ? 128 : 0) + (n & 127)); }
__global__ void k_transpose(const float* __restrict__ W, int K, int N, bf16_t* __restrict__ Wt, int mode) {
    __shared__ float tile[32][33];
    const int n0 = blockIdx.x * 32, k0 = blockIdx.y * 32;
    for (int i = threadIdx.y; i < 32; i += 8) tile[i][threadIdx.x] = W[(size_t)(k0 + i) * N + n0 + threadIdx.x];
    __syncthreads();
    for (int i = threadIdx.y; i < 32; i += 8) { const int row = rowmap(mode, n0 + i); Wt[(size_t)row * K + k0 + threadIdx.x] = f2bf(tile[threadIdx.x][i]); }
}
__global__ void k_cvt(const float* __restrict__ x, bf16_t* __restrict__ xb, size_t n) {
    for (size_t i = (size_t)blockIdx.x * blockDim.x + threadIdx.x; i < n; i += (size_t)gridDim.x * blockDim.x) xb[i] = f2bf(x[i]);
}
__global__ void k_s5_params(const float* a_re, const float* a_im, const float* log_dt, const float* b_re, const float* b_im, float2* lam, float* bbr, float* bbi) {
    const int idx = blockIdx.x * blockDim.x + threadIdx.x; if (idx >= NG * NP) return;
    const int g = idx / NP;
    const double dt = exp((double)log_dt[g]);
    const double lr = fmin((double)a_re[idx], -1e-4), li = (double)a_im[idx];
    const double mag = exp(lr * dt), lbr = mag * cos(li * dt), lbi = mag * sin(li * dt);
    const double zr = lbr - 1.0, zi = lbi, den = lr * lr + li * li;
    const double fr = (zr * lr + zi * li) / den, fi = (zi * lr - zr * li) / den;
    lam[idx] = make_float2((float)lbr, (float)lbi);
    for (int h = 0; h < GS; ++h) { const double br = b_re[idx * GS + h], bi = b_im[idx * GS + h];
        bbr[idx * GS + h] = (float)(fr * br - fi * bi); bbi[idx * GS + h] = (float)(fr * bi + fi * br); }
}
template <class Epi> __global__ void __launch_bounds__(256) k_gemm(const bf16_t* __restrict__ A, int lda, const bf16_t* __restrict__ Bt, int ldb, int K, Epi E) {
    __shared__ float As[16][68], Bs[16][68];
    const int tid = threadIdx.x, tx = tid & 15, ty = tid >> 4, m0 = blockIdx.y * 64, n0 = blockIdx.x * 64;
    float acc[4][4];
#pragma unroll
    for (int i = 0; i < 4; ++i)
#pragma unroll
        for (int j = 0; j < 4; ++j) acc[i][j] = 0.f;
    const int lr = tid >> 2, lk = (tid & 3) * 4;
    for (int k0 = 0; k0 < K; k0 += 16) {
        const ushort4 av = *(const ushort4*)(A + (size_t)(m0 + lr) * lda + k0 + lk);
        const ushort4 bv = *(const ushort4*)(Bt + (size_t)(n0 + lr) * ldb + k0 + lk);
        As[lk + 0][lr] = bf2f(av.x); As[lk + 1][lr] = bf2f(av.y); As[lk + 2][lr] = bf2f(av.z); As[lk + 3][lr] = bf2f(av.w);
        Bs[lk + 0][lr] = bf2f(bv.x); Bs[lk + 1][lr] = bf2f(bv.y); Bs[lk + 2][lr] = bf2f(bv.z); Bs[lk + 3][lr] = bf2f(bv.w);
        __syncthreads();
#pragma unroll
        for (int k = 0; k < 16; ++k) {
            const float4 a = *(const float4*)&As[k][ty * 4], b = *(const float4*)&Bs[k][tx * 4];
            const float aa[4] = {a.x, a.y, a.z, a.w}, bb[4] = {b.x, b.y, b.z, b.w};
#pragma unroll
            for (int i = 0; i < 4; ++i)
#pragma unroll
                for (int j = 0; j < 4; ++j) acc[i][j] += aa[i] * bb[j];
        }
        __syncthreads();
    }
#pragma unroll
    for (int i = 0; i < 4; ++i)
#pragma unroll
        for (int j = 0; j < 4; ++j) E(m0 + ty * 4 + i, n0 + tx * 4 + j, acc[i][j]);
}
__global__ void __launch_bounds__(256) k_glu(const bf16_t* __restrict__ A, int lda, const bf16_t* __restrict__ Bt, int K, bf16_t* Z) {
    __shared__ float As[16][68], Bw[16][68], Bv[16][68];
    const int tid = threadIdx.x, tx = tid & 15, ty = tid >> 4, m0 = blockIdx.y * 64, n0 = blockIdx.x * 64;
    float aw[4][4], avv[4][4];
#pragma unroll
    for (int i = 0; i < 4; ++i)
#pragma unroll
        for (int j = 0; j < 4; ++j) { aw[i][j] = 0.f; avv[i][j] = 0.f; }
    const int lr = tid >> 2, lk = (tid & 3) * 4;
    const int rw = rowmap(1, n0 + lr), rv = rowmap(2, n0 + lr);
    for (int k0 = 0; k0 < K; k0 += 16) {
        const ushort4 a4 = *(const ushort4*)(A + (size_t)(m0 + lr) * lda + k0 + lk);
        const ushort4 w4 = *(const ushort4*)(Bt + (size_t)rw * K + k0 + lk);
        const ushort4 v4 = *(const ushort4*)(Bt + (size_t)rv * K + k0 + lk);
        As[lk + 0][lr] = bf2f(a4.x); As[lk + 1][lr] = bf2f(a4.y); As[lk + 2][lr] = bf2f(a4.z); As[lk + 3][lr] = bf2f(a4.w);
        Bw[lk + 0][lr] = bf2f(w4.x); Bw[lk + 1][lr] = bf2f(w4.y); Bw[lk + 2][lr] = bf2f(w4.z); Bw[lk + 3][lr] = bf2f(w4.w);
        Bv[lk + 0][lr] = bf2f(v4.x); Bv[lk + 1][lr] = bf2f(v4.y); Bv[lk + 2][lr] = bf2f(v4.z); Bv[lk + 3][lr] = bf2f(v4.w);
        __syncthreads();
#pragma unroll
        for (int k = 0; k < 16; ++k) {
            const float4 a = *(const float4*)&As[k][ty * 4], w = *(const float4*)&Bw[k][tx * 4], v = *(const float4*)&Bv[k][tx * 4];
            const float aa[4] = {a.x, a.y, a.z, a.w}, ww[4] = {w.x, w.y, w.z, w.w}, vv[4] = {v.x, v.y, v.z, v.w};
#pragma unroll
            for (int i = 0; i < 4; ++i)
#pragma unroll
                for (int j = 0; j < 4; ++j) { aw[i][j] += aa[i] * ww[j]; avv[i][j] += aa[i] * vv[j]; }
        }
        __syncthreads();
    }
#pragma unroll
    for (int i = 0; i < 4; ++i)
#pragma unroll
        for (int j = 0; j < 4; ++j) { const int row = m0 + ty * 4 + i, col = n0 + tx * 4 + j; bf16_t* p = Z + (size_t)row * DIN + O_GB + col;
            *p = f2bf(aw[i][j] * sigmoid_f(avv[i][j]) * bf2f(*p)); }
}
__global__ void __launch_bounds__(128) k_rglru(bf16_t* Z, const float* conv_w, const float* conv_b, const float* wa, const float* ba, const float* wx, const float* bx, const float* lam) {
    extern __shared__ float sm[];
    float* s_wa = sm; float* s_wx = sm + HD * HD; float* s_xc = sm + 2 * HD * HD;
    const int b = blockIdx.x / HEADS, hd = blockIdx.x % HEADS, j = threadIdx.x, ch = hd * HD + j;
    for (int i = j; i < HD * HD; i += 128) { s_wa[i] = wa[(size_t)hd * HD * HD + i]; s_wx[i] = wx[(size_t)hd * HD * HD + i]; }
    const float cw0 = conv_w[0 * D + ch], cw1 = conv_w[1 * D + ch], cw2 = conv_w[2 * D + ch], cw3 = conv_w[3 * D + ch], cb = conv_b[ch];
    const float bav = ba[ch], bxv = bx[ch];
    const float lac = -8.f * log1pf(expf(-lam[ch]));
    float x1 = 0.f, x2 = 0.f, x3 = 0.f, h = 0.f;
    __syncthreads();
    bf16_t* zr = Z + (size_t)b * SEQ * DIN;
    for (int t = 0; t < SEQ; ++t) {
        const float x0 = bf2f(zr[(size_t)t * DIN + O_XR + ch]);
        const float xc = cw0 * x3 + cw1 * x2 + cw2 * x1 + cw3 * x0 + cb;
        x3 = x2; x2 = x1; x1 = x0;
        s_xc[j] = xc;
        __syncthreads();
        float rp = bav, ip = bxv;
#pragma unroll 8
        for (int i = 0; i < HD; ++i) { const float v = s_xc[i]; rp += v * s_wa[i * HD + j]; ip += v * s_wx[i * HD + j]; }
        __syncthreads();
        const float r = sigmoid_f(rp), ig = sigmoid_f(ip);
        const float la = r * lac, a = expf(la), mult = sqrtf(-expm1f(2.f * la));
        h = a * h + mult * (ig * xc);
        bf16_t* g = zr + (size_t)t * DIN + O_GR + ch;
        *g = f2bf(h * bf2f(*g));
    }
}
__global__ void __launch_bounds__(64) k_s5(bf16_t* Z, const float2* lamb, const float* bbr, const float* bbi, const float* c_re, const float* c_im, const float* dd) {
    const int b = blockIdx.x / NG, g = blockIdx.x % NG, p = threadIdx.x;
    float br[GS], bi[GS], cr[GS], ci[GS];
#pragma unroll
    for (int h = 0; h < GS; ++h) { br[h] = bbr[(g * NP + p) * GS + h]; bi[h] = bbi[(g * NP + p) * GS + h]; cr[h] = c_re[(g * GS + h) * NP + p]; ci[h] = c_im[(g * GS + h) * NP + p]; }
    const float2 l = lamb[g * NP + p];
    const float dv = dd[g * GS + (p & 15)];
    float hr = 0.f, hi = 0.f;
    bf16_t* zr = Z + (size_t)b * SEQ * DIN + O_U + g * GS;
    for (int t = 0; t < SEQ; ++t) {
        const float ul = bf2f(zr[(size_t)t * DIN + (p & 15)]);
        float bur = 0.f, bui = 0.f;
#pragma unroll
        for (int h = 0; h < GS; ++h) { const float u = __shfl(ul, h); bur += br[h] * u; bui += bi[h] * u; }
        const float nr = l.x * hr - l.y * hi + bur, ni = l.x * hi + l.y * hr + bui; hr = nr; hi = ni;
        float yv = 0.f;
#pragma unroll
        for (int h = 0; h < GS; ++h) { float v = cr[h] * hr - ci[h] * hi;
#pragma unroll
            for (int o = 1; o < 64; o <<= 1) v += __shfl_xor(v, o);
            yv = (p == h) ? v : yv; }
        if (p < GS) zr[(size_t)t * DIN + p] = f2bf(gelu_tanh(yv + dv * ul));
    }
}
__global__ void __launch_bounds__(256) k_ln(float* X, const float* g, const float* bt, bf16_t* xb) {
    __shared__ float red[8];
    const int row = blockIdx.x, tid = threadIdx.x; float* xr = X + (size_t)row * D;
    float v[8]; float s = 0.f;
#pragma unroll
    for (int i = 0; i < 8; ++i) { v[i] = xr[tid + 256 * i]; s += v[i]; }
#pragma unroll
    for (int o = 1; o < 64; o <<= 1) s += __shfl_xor(s, o);
    if ((tid & 63) == 0) red[tid >> 6] = s;
    __syncthreads();
    const float mean = (red[0] + red[1] + red[2] + red[3]) * (1.f / D);
    float q = 0.f;
#pragma unroll
    for (int i = 0; i < 8; ++i) { v[i] -= mean; q += v[i] * v[i]; }
#pragma unroll
    for (int o = 1; o < 64; o <<= 1) q += __shfl_xor(q, o);
    if ((tid & 63) == 0) red[4 + (tid >> 6)] = q;
    __syncthreads();
    const float rstd = rsqrtf((red[4] + red[5] + red[6] + red[7]) * (1.f / D) + LN_EPS);
#pragma unroll
    for (int i = 0; i < 8; ++i) { const int c = tid + 256 * i; const float y = v[i] * rstd * g[c] + bt[c]; xr[c] = y; if (xb) xb[(size_t)row * D + c] = f2bf(y); }
}
struct EpiZ { bf16_t* Z; __device__ void operator()(int r, int c, float a) const {
    float v = a; if (c >= O_GR && c < O_U) v = gelu_tanh(a); else if (c >= O_GA) v = sigmoid_f(a); Z[(size_t)r * DIN + c] = f2bf(v); } };
struct EpiMix { bf16_t* Z; __device__ void operator()(int r, int c, float a) const {
    bf16_t* p = Z + (size_t)r * DIN + O_GA + c; *p = f2bf(bf2f(*p) * a + bf2f(Z[(size_t)r * DIN + O_GB + c])); } };
struct EpiR1 { const float* x; float* out; __device__ void operator()(int r, int c, float a) const { out[(size_t)r * D + c] = ALPHA * x[(size_t)r * D + c] + a; } };
struct EpiUp { bf16_t* H; const float* b; __device__ void operator()(int r, int c, float a) const { const float v = fmaxf(a + b[c], 0.f); H[(size_t)r * DFF + c] = f2bf(v * v); } };
struct EpiR2 { float* out; const float* b; __device__ void operator()(int r, int c, float a) const { float* p = out + (size_t)r * D + c; *p = ALPHA * (*p) + a + b[c]; } };
}

namespace pg8 {
#define PG8_LAS __attribute__((address_space(3)))
typedef short bf16x8 __attribute__((ext_vector_type(8)));
typedef float f32x4 __attribute__((ext_vector_type(4)));
typedef unsigned u32x4 __attribute__((ext_vector_type(4)));
typedef unsigned u32x2 __attribute__((ext_vector_type(2)));
constexpr int BM = 256, BK = 64, HALF = 128, HTB = HALF * BK * 2  , STAGE_BYTES = 8 * HTB, NXCD = 8, WGM = 8;
__host__ __device__ __forceinline__ int lds_byte(int r, int c) { const int st = (r >> 4) * 2 + (c >> 5), rr = r & 15, cc = c & 31, ob = rr * 64 + cc * 2; return st * 1024 + (ob ^ (((ob >> 9) & 1) << 5)); }
__host__ __device__ __forceinline__ void stage_rc(int b, int& R, int& C) { const int st = b / 1024, sb = b % 1024, swz = sb ^ (((sb >> 9) & 1) << 5); R = (st >> 1) * 16 + swz / 64; C = (st & 1) * 32 + (swz % 64) / 2; }
__host__ __device__ __forceinline__ int perm32(int rho) { const int n = rho >> 4, i = rho & 15; return 8 * (i >> 2) + 4 * n + (i & 3); }
struct Unit { int pm, pn; };
struct Gemm { const bf16_t* A; int lda; const bf16_t* Bt; int ldb; int M, N, K; };
struct StaticOrder {
    int nM, nN, nwg, G, c;
    __host__ __device__ void init(int M_, int N_, int G_, int c_) { nM = M_ / BM; nN = N_ / BM; nwg = nM * nN; G = G_; c = c_; }
    __host__ __device__ bool next(int i, Unit& u) const {
        const long L = (long)i * G + c; if (L >= nwg) return false;
        int wgid = (int)L; { const int q = nwg / NXCD, r = nwg % NXCD, xcd = wgid % NXCD, off = wgid / NXCD; wgid = (xcd < r ? xcd * (q + 1) : r * (q + 1) + (xcd - r) * q) + off; }
        const int nig = WGM * nN, gid = wgid / nig, fm = gid * WGM, gsz = (nM - fm) < WGM ? (nM - fm) : WGM;
        u.pm = fm + ((wgid % nig) % gsz); u.pn = (wgid % nig) / gsz; return true;
    }
    __device__ __forceinline__ void a_ready(const Unit&) const {}
    __device__ __forceinline__ void done(const Unit&) const {}
};
__device__ __forceinline__ unsigned cvt_pk_bf16(float lo, float hi) { unsigned r; asm volatile("v_cvt_pk_bf16_f32 %0, %1, %2" : "=v"(r) : "v"(lo), "v"(hi)); return r; }
__device__ __forceinline__ float bf_lo(unsigned w) { return __uint_as_float(w << 16); }
__device__ __forceinline__ float bf_hi(unsigned w) { return __uint_as_float(w & 0xffff0000u); }
__device__ __forceinline__ float sigm(float x) { return __builtin_amdgcn_rcpf(1.f + __expf(-x)); }
__device__ __forceinline__ float gelu_t(float x) { const float u = 1.5957691216057308f * (x + 0.044715f * x * x * x); return x * sigm(u); }

struct EpiZ {
    static constexpr bool PERM = true, AFTER_DRAIN = false;
    bf16_t* Z;
    __device__ __forceinline__ void operator()(const f32x4 (&acc)[2][2][4][2], const Unit& u, int wr, int wc, int fr, int fq) const {
        const int row0 = u.pm * BM + wr * 64 + fr, col0 = u.pn * BM + wc * 32 + 8 * fq;
        const int act = (u.pn >= 20) ? 2 : ((u.pn >= 8 && u.pn < 16) ? 1 : 0);
#pragma unroll
        for (int ai = 0; ai < 2; ++ai)
#pragma unroll
            for (int m = 0; m < 4; ++m) { bf16_t* rowp = Z + (size_t)(row0 + ai * HALF + m * 16) * DIN + col0;
#pragma unroll
                for (int bj = 0; bj < 2; ++bj) { f32x4 v0 = acc[ai][bj][m][0], v1 = acc[ai][bj][m][1];
                    if (act == 1) {
#pragma unroll
                        for (int j = 0; j < 4; ++j) { v0[j] = gelu_t(v0[j]); v1[j] = gelu_t(v1[j]); } }
                    else if (act == 2) {
#pragma unroll
                        for (int j = 0; j < 4; ++j) { v0[j] = sigm(v0[j]); v1[j] = sigm(v1[j]); } }
                    u32x4 w; w.x = cvt_pk_bf16(v0[0], v0[1]); w.y = cvt_pk_bf16(v0[2], v0[3]); w.z = cvt_pk_bf16(v1[0], v1[1]); w.w = cvt_pk_bf16(v1[2], v1[3]);
                    *(u32x4*)(rowp + bj * HALF) = w; } }
    }
};
struct EpiGlu {
    static constexpr bool PERM = true, AFTER_DRAIN = false;
    bf16_t* Z;
    __device__ __forceinline__ void operator()(const f32x4 (&acc)[2][2][4][2], const Unit& u, int wr, int wc, int fr, int fq) const {
        const int row0 = u.pm * BM + wr * 64 + fr, col0 = u.pn * HALF + wc * 32 + 8 * fq;
#pragma unroll
        for (int ai = 0; ai < 2; ++ai)
#pragma unroll
            for (int m = 0; m < 4; ++m) { bf16_t* p = Z + (size_t)(row0 + ai * HALF + m * 16) * DIN + O_GB + col0;
                const u32x4 g = *(const u32x4*)p;
                const f32x4 w0 = acc[ai][0][m][0], w1 = acc[ai][0][m][1], v0 = acc[ai][1][m][0], v1 = acc[ai][1][m][1];
                u32x4 o;
                o.x = cvt_pk_bf16(w0[0] * sigm(v0[0]) * bf_lo(g.x), w0[1] * sigm(v0[1]) * bf_hi(g.x));
                o.y = cvt_pk_bf16(w0[2] * sigm(v0[2]) * bf_lo(g.y), w0[3] * sigm(v0[3]) * bf_hi(g.y));
                o.z = cvt_pk_bf16(w1[0] * sigm(v1[0]) * bf_lo(g.z), w1[1] * sigm(v1[1]) * bf_hi(g.z));
                o.w = cvt_pk_bf16(w1[2] * sigm(v1[2]) * bf_lo(g.w), w1[3] * sigm(v1[3]) * bf_hi(g.w));
                *(u32x4*)p = o; }
    }
};
struct EpiMix {
    static constexpr bool PERM = true, AFTER_DRAIN = false;
    bf16_t* Z;
    __device__ __forceinline__ void operator()(const f32x4 (&acc)[2][2][4][2], const Unit& u, int wr, int wc, int fr, int fq) const {
        const int row0 = u.pm * BM + wr * 64 + fr, col0 = u.pn * BM + wc * 32 + 8 * fq;
#pragma unroll
        for (int ai = 0; ai < 2; ++ai)
#pragma unroll
            for (int m = 0; m < 4; ++m) { bf16_t* rowp = Z + (size_t)(row0 + ai * HALF + m * 16) * DIN + col0;
#pragma unroll
                for (int bj = 0; bj < 2; ++bj) { bf16_t* pa = rowp + O_GA + bj * HALF; const bf16_t* pb = rowp + O_GB + bj * HALF;
                    const u32x4 ga = *(const u32x4*)pa, yb = *(const u32x4*)pb; const f32x4 a0 = acc[ai][bj][m][0], a1 = acc[ai][bj][m][1];
                    u32x4 o;
                    o.x = cvt_pk_bf16(bf_lo(ga.x) * a0[0] + bf_lo(yb.x), bf_hi(ga.x) * a0[1] + bf_hi(yb.x));
                    o.y = cvt_pk_bf16(bf_lo(ga.y) * a0[2] + bf_lo(yb.y), bf_hi(ga.y) * a0[3] + bf_hi(yb.y));
                    o.z = cvt_pk_bf16(bf_lo(ga.z) * a1[0] + bf_lo(yb.z), bf_hi(ga.z) * a1[1] + bf_hi(yb.z));
                    o.w = cvt_pk_bf16(bf_lo(ga.w) * a1[2] + bf_lo(yb.w), bf_hi(ga.w) * a1[3] + bf_hi(yb.w));
                    *(u32x4*)pa = o; } }
    }
};
struct EpiR1 {
    static constexpr bool PERM = false, AFTER_DRAIN = false;
    const float* x; float* out;
    __device__ __forceinline__ void operator()(const f32x4 (&acc)[2][2][4][2], const Unit& u, int wr, int wc, int fr, int fq) const {
        const int row0 = u.pm * BM + wr * 64 + fr, col0 = u.pn * BM + wc * 32 + 4 * fq;
#pragma unroll
        for (int ai = 0; ai < 2; ++ai)
#pragma unroll
            for (int m = 0; m < 4; ++m) { const size_t off = (size_t)(row0 + ai * HALF + m * 16) * D + col0;
#pragma unroll
                for (int bj = 0; bj < 2; ++bj)
#pragma unroll
                    for (int n = 0; n < 2; ++n) { const f32x4 xv = *(const f32x4*)(x + off + bj * HALF + n * 16); *(f32x4*)(out + off + bj * HALF + n * 16) = xv * ALPHA + acc[ai][bj][m][n]; }
                asm volatile("" ::: "memory"); }
    }
};
struct EpiUp {
    static constexpr bool PERM = true, AFTER_DRAIN = false;
    bf16_t* H; const float* bias;
    __device__ __forceinline__ void operator()(const f32x4 (&acc)[2][2][4][2], const Unit& u, int wr, int wc, int fr, int fq) const {
        const int row0 = u.pm * BM + wr * 64 + fr, col0 = u.pn * BM + wc * 32 + 8 * fq;
        f32x4 bv[2][2];
#pragma unroll
        for (int bj = 0; bj < 2; ++bj)
#pragma unroll
            for (int n = 0; n < 2; ++n) bv[bj][n] = *(const f32x4*)(bias + col0 + bj * HALF + 4 * n);
#pragma unroll
        for (int ai = 0; ai < 2; ++ai)
#pragma unroll
            for (int m = 0; m < 4; ++m) { bf16_t* rowp = H + (size_t)(row0 + ai * HALF + m * 16) * DFF + col0;
#pragma unroll
                for (int bj = 0; bj < 2; ++bj) { f32x4 v0 = acc[ai][bj][m][0] + bv[bj][0], v1 = acc[ai][bj][m][1] + bv[bj][1];
#pragma unroll
                    for (int j = 0; j < 4; ++j) { v0[j] = fmaxf(v0[j], 0.f); v0[j] *= v0[j]; v1[j] = fmaxf(v1[j], 0.f); v1[j] *= v1[j]; }
                    u32x4 w; w.x = cvt_pk_bf16(v0[0], v0[1]); w.y = cvt_pk_bf16(v0[2], v0[3]); w.z = cvt_pk_bf16(v1[0], v1[1]); w.w = cvt_pk_bf16(v1[2], v1[3]);
                    *(u32x4*)(rowp + bj * HALF) = w; } }
    }
};
struct EpiR2 {
    static constexpr bool PERM = false, AFTER_DRAIN = false;
    float* out; const float* bias;
    __device__ __forceinline__ void operator()(const f32x4 (&acc)[2][2][4][2], const Unit& u, int wr, int wc, int fr, int fq) const {
        const int row0 = u.pm * BM + wr * 64 + fr, col0 = u.pn * BM + wc * 32 + 4 * fq;
        f32x4 bv[2][2];
#pragma unroll
        for (int bj = 0; bj < 2; ++bj)
#pragma unroll
            for (int n = 0; n < 2; ++n) bv[bj][n] = *(const f32x4*)(bias + col0 + bj * HALF + n * 16);
#pragma unroll
        for (int ai = 0; ai < 2; ++ai)
#pragma unroll
            for (int m = 0; m < 4; ++m) { const size_t off = (size_t)(row0 + ai * HALF + m * 16) * D + col0;
#pragma unroll
                for (int bj = 0; bj < 2; ++bj)
#pragma unroll
                    for (int n = 0; n < 2; ++n) { float* p = out + off + bj * HALF + n * 16; const f32x4 xv = *(const f32x4*)p; *(f32x4*)p = xv * ALPHA + acc[ai][bj][m][n] + bv[bj][n]; }
                asm volatile("" ::: "memory"); }
    }
};

template <class Epi, class Sched, bool ALIGN_EPI = true>
__device__ __forceinline__ void gemm_phase(PG8_LAS unsigned char* lds, const Gemm g, const Sched& S, const Epi& E) {
    const int tid = threadIdx.x, wid = __builtin_amdgcn_readfirstlane(tid >> 6), lane = tid & 63, wr = wid >> 2, wc = wid & 3, fr = lane & 15, fq = lane >> 4;
    const int K = g.K, nt = K / BK;
    unsigned voffA[2], voffB[2];
#pragma unroll
    for (int i = 0; i < 2; ++i) { int R, C; stage_rc(tid * 16 + i * 8192, R, C); const int Rb = Epi::PERM ? ((R & ~31) + perm32(R & 31)) : R;
        voffA[i] = (unsigned)(R * g.lda + C) * 2u; voffB[i] = (unsigned)(Rb * g.ldb + C) * 2u; }
    const size_t kstep = (size_t)(BK * 2);
    const size_t hstepA = (size_t)HALF * g.lda * 2, hstepB = (size_t)HALF * g.ldb * 2;
    const size_t tstepA = 2 * hstepA, tstepB = 2 * hstepB;
    const unsigned ldsw = (unsigned)wid * 1024u;
    const int aoff = lds_byte(wr * 64 + fr, fq * 8), boff = lds_byte(wc * 32 + fr, fq * 8);
#define PG8_SA(b, h) (((b) * 2 + (h)) * HTB)
#define PG8_SB(b, h) ((4 + (b) * 2 + (h)) * HTB)
#define PG8_STAGE(bufoff, gbase, voff) do { _Pragma("unroll") for (int _i = 0; _i < 2; ++_i) \
        __builtin_amdgcn_global_load_lds((const unsigned*)((const char*)(gbase) + (voff)[_i]), (PG8_LAS unsigned*)(lds + (bufoff) + ldsw + _i * 8192), 16, 0, 0); } while (0)
#define PG8_LDA(dst, b, h) do { _Pragma("unroll") for (int m = 0; m < 4; ++m) _Pragma("unroll") for (int k = 0; k < 2; ++k) dst[m][k] = *(const PG8_LAS bf16x8*)(lds + PG8_SA(b, h) + aoff + m * 2048 + k * 1024); } while (0)
#define PG8_LDB(dst, b, h) do { _Pragma("unroll") for (int n = 0; n < 2; ++n) _Pragma("unroll") for (int k = 0; k < 2; ++k) dst[n][k] = *(const PG8_LAS bf16x8*)(lds + PG8_SB(b, h) + boff + n * 2048 + k * 1024); } while (0)
#define PG8_MMA(ai, bj, At, Bt) do { __builtin_amdgcn_s_setprio(1); _Pragma("unroll") for (int m = 0; m < 4; ++m) _Pragma("unroll") for (int n = 0; n < 2; ++n) _Pragma("unroll") for (int k = 0; k < 2; ++k) \
        acc[ai][bj][m][n] = __builtin_amdgcn_mfma_f32_16x16x32_bf16(Bt[n][k], At[m][k], acc[ai][bj][m][n], 0, 0, 0); __builtin_amdgcn_s_setprio(0); } while (0)
#define PG8_WAIT_V(n) asm volatile("s_waitcnt vmcnt(" #n ")" ::: "memory")
#define PG8_WAIT_L(n) asm volatile("s_waitcnt lgkmcnt(" #n ")" ::: "memory")
#define PG8_BAR __builtin_amdgcn_s_barrier()
#define PG8_SCHED __builtin_amdgcn_sched_barrier(0)
    Unit cur, nxt; int ui = 0;
    if (!S.next(0, cur)) return;
    f32x4 acc[2][2][4][2];
#pragma unroll
    for (int a = 0; a < 2; ++a)
#pragma unroll
        for (int b = 0; b < 2; ++b)
#pragma unroll
            for (int m = 0; m < 4; ++m)
#pragma unroll
                for (int n = 0; n < 2; ++n) acc[a][b][m][n] = (f32x4){0.f, 0.f, 0.f, 0.f};
    bf16x8 At[4][2], B0[2][2], B1[2][2];
    const char* cA = (const char*)g.A + (size_t)cur.pm * tstepA; const char* cB = (const char*)g.Bt + (size_t)cur.pn * tstepB;
    S.a_ready(cur);
    PG8_STAGE(PG8_SB(0, 0), cB, voffB); PG8_STAGE(PG8_SB(0, 1), cB + hstepB, voffB); PG8_STAGE(PG8_SA(0, 0), cA, voffA); PG8_STAGE(PG8_SA(0, 1), cA + hstepA, voffA);
    if (wr == 1) PG8_BAR;
    PG8_WAIT_V(2); PG8_BAR;
    PG8_STAGE(PG8_SB(1, 0), cB + kstep, voffB); PG8_STAGE(PG8_SA(1, 0), cA + kstep, voffA); PG8_STAGE(PG8_SB(1, 1), cB + hstepB + kstep, voffB);
    PG8_WAIT_V(6); PG8_BAR;
    for (;;) {
        const bool has_next = S.next(ui + 1, nxt);
        const char* nA = has_next ? (const char*)g.A + (size_t)nxt.pm * tstepA : cA; const char* nB = has_next ? (const char*)g.Bt + (size_t)nxt.pn * tstepB : cB;
        for (int t = 0; t < nt; t += 2) {
            const bool last = (t == nt - 2);
            const char* a1 = cA + (size_t)(t + 1) * kstep;
            const char* a2 = last ? nA : cA + (size_t)(t + 2) * kstep; const char* b2 = last ? nB : cB + (size_t)(t + 2) * kstep;
            const char* a3 = a2 + kstep; const char* b3 = b2 + kstep;
            if (last && has_next) S.a_ready(nxt);
            PG8_LDB(B0, 0, 0); PG8_LDB(B1, 0, 1); PG8_SCHED; PG8_LDA(At, 0, 0); PG8_STAGE(PG8_SA(1, 1), a1 + hstepA, voffA);
            PG8_WAIT_V(8); PG8_WAIT_L(0); PG8_BAR; PG8_MMA(0, 0, At, B0); PG8_MMA(0, 1, At, B1); PG8_BAR; PG8_SCHED;
            PG8_LDA(At, 0, 1); PG8_STAGE(PG8_SB(0, 0), b2, voffB); PG8_STAGE(PG8_SB(0, 1), b2 + hstepB, voffB); PG8_STAGE(PG8_SA(0, 0), a2, voffA);
            PG8_WAIT_V(8); PG8_WAIT_L(0); PG8_BAR; PG8_MMA(1, 0, At, B0); PG8_MMA(1, 1, At, B1); PG8_BAR; PG8_SCHED;
            PG8_LDB(B0, 1, 0); PG8_LDB(B1, 1, 1); PG8_SCHED; PG8_LDA(At, 1, 0); PG8_STAGE(PG8_SA(0, 1), a2 + hstepA, voffA);
            PG8_WAIT_V(8); PG8_WAIT_L(0); PG8_BAR; PG8_MMA(0, 0, At, B0); PG8_MMA(0, 1, At, B1); PG8_BAR; PG8_SCHED;
            PG8_LDA(At, 1, 1); PG8_STAGE(PG8_SB(1, 0), b3, voffB); PG8_STAGE(PG8_SB(1, 1), b3 + hstepB, voffB); PG8_STAGE(PG8_SA(1, 0), a3, voffA);
            PG8_WAIT_V(8); PG8_WAIT_L(0); PG8_BAR; PG8_MMA(1, 0, At, B0); PG8_MMA(1, 1, At, B1); PG8_BAR; PG8_SCHED;
        }
        if constexpr (ALIGN_EPI) { if (wr == 0) PG8_BAR; }
        E(acc, cur, wr, wc, fr, fq); S.done(cur);
        if (!has_next) break;
#pragma unroll
        for (int a = 0; a < 2; ++a)
#pragma unroll
            for (int b = 0; b < 2; ++b)
#pragma unroll
                for (int m = 0; m < 4; ++m)
#pragma unroll
                    for (int n = 0; n < 2; ++n) acc[a][b][m][n] = (f32x4){0.f, 0.f, 0.f, 0.f};
        cur = nxt; cA = nA; cB = nB; ++ui;
        if constexpr (ALIGN_EPI) { if (wr == 1) PG8_BAR; }
    }
    PG8_WAIT_V(0);
    if constexpr (!ALIGN_EPI) { if (wr == 0) PG8_BAR; }
    PG8_BAR;
#undef PG8_SA
#undef PG8_SB
#undef PG8_STAGE
#undef PG8_LDA
#undef PG8_LDB
#undef PG8_MMA
#undef PG8_WAIT_V
#undef PG8_WAIT_L
#undef PG8_BAR
#undef PG8_SCHED
}
}

namespace scan {
#define SLAS __attribute__((address_space(3)))
typedef short bf16x8 __attribute__((ext_vector_type(8)));
typedef float f32x16 __attribute__((ext_vector_type(16)));
typedef float f32x4 __attribute__((ext_vector_type(4)));
typedef unsigned u32x4 __attribute__((ext_vector_type(4)));
typedef unsigned u32x2 __attribute__((ext_vector_type(2)));
typedef __bf16 bf16x2v __attribute__((ext_vector_type(2)));
typedef float f32x2v __attribute__((ext_vector_type(2)));
#define MFMA32(a, b, c) __builtin_amdgcn_mfma_f32_32x32x16_bf16((a), (b), (c), 0, 0, 0)
__device__ __forceinline__ unsigned pk2c(float a, float b) { f32x2v f = {a, b}; bf16x2v r = __builtin_convertvector(f, bf16x2v); return __builtin_bit_cast(unsigned, r); }
__device__ __forceinline__ bf16x8 pack8(float a0, float a1, float a2, float a3, float a4, float a5, float a6, float a7) {
    u32x4 p; p.x = pk2c(a0, a1); p.y = pk2c(a2, a3); p.z = pk2c(a4, a5); p.w = pk2c(a6, a7); return __builtin_bit_cast(bf16x8, p); }
__device__ __forceinline__ int crow(int i, int hf) { return (i & 3) + 8 * (i >> 2) + 4 * hf; }
__device__ __forceinline__ float sigm(float x) { return __builtin_amdgcn_rcpf(1.f + __expf(-x)); }
__device__ __forceinline__ float gelu_t(float x) { const float u = 1.5957691216057308f * (x + 0.044715f * x * x * x); return x * sigm(u); }

constexpr int RG_NC = 32, RG_L = SEQ / RG_NC, RG_STEPS = RG_L / 16, RG_NS = NB * RG_NC;
constexpr int S5_NC = 256, S5_L = SEQ / S5_NC, S5_NS = NB * S5_NC, S5_UNITS = (S5_NS / 32) * NG;
constexpr size_t WS_RGP = WS_X1B, WS_RGS = WS_RGP + 512 * 1024, WS_RGH = WS_RGS + 512 * 1024;
constexpr size_t WS_S5S = WS_X1B + 2 * MiB, WS_S5H = WS_S5S + 16 * MiB;
static_assert(WS_S5H + 16 * MiB <= WS_Z, "scan scratch fits the X1B region");
constexpr int RG_HB_LDS = 51200;

__device__ __forceinline__ void rglru_pack_weights(const float* __restrict__ wa, const float* __restrict__ wx, bf16_t* RGW, int idx) {
    const int lane = idx & 63, ks = (idx >> 6) & 7, gate = (idx >> 9) & 1, w4 = (idx >> 10) & 3, hd = idx >> 12;
    const float* p = (gate ? wx : wa) + (size_t)hd * HD * HD + (size_t)(16 * ks + 8 * (lane >> 5)) * HD + w4 * 32 + (lane & 31);
    ((bf16x8*)RGW)[idx] = pack8(p[0], p[HD], p[2 * HD], p[3 * HD], p[4 * HD], p[5 * HD], p[6 * HD], p[7 * HD]);
}
template <bool PASS_B>
__device__ __forceinline__ void rglru_pass(SLAS unsigned char* lds, bf16_t* Z, const float* __restrict__ conv_w, const float* __restrict__ conv_b, const bf16_t* __restrict__ RGW, const float* __restrict__ ba,
                                           const float* __restrict__ bxp, const float* __restrict__ lam, float* RGP, float* RGS, const float* RGH, int bx, int G) {
    const int tid = threadIdx.x, lane = tid & 63, wave = __builtin_amdgcn_readfirstlane(tid >> 6), hb = wave >> 2, w4 = wave & 3, t4 = tid & 255;
    const int col = lane & 31, hf = lane >> 5;
    SLAS unsigned char* base = lds + hb * RG_HB_LDS;
    for (int ub = bx; ub < 256; ub += G) {
        const int unit = 2 * ub + hb, hd = unit & 15, sp = unit >> 4;
        const int cs = t4 >> 7, cch = t4 & 127, s_conv = 2 * sp + cs, chc = hd * HD + cch;
        const int cconv = s_conv % RG_NC;
        const bf16_t* zx = Z + (size_t)((s_conv / RG_NC) * SEQ + cconv * RG_L) * DIN + O_XR + chc;
        const float cw0 = conv_w[0 * D + chc], cw1 = conv_w[1 * D + chc], cw2 = conv_w[2 * D + chc], cw3 = conv_w[3 * D + chc], cb = conv_b[chc];
        float x1 = 0.f, x2 = 0.f, x3 = 0.f;
        if (cconv > 0) { x1 = bf2f(zx[-(ptrdiff_t)DIN]); x2 = bf2f(zx[-2 * (ptrdiff_t)DIN]); x3 = bf2f(zx[-3 * (ptrdiff_t)DIN]); }
        const int s_scan = 2 * sp + hf, ch = hd * HD + w4 * 32 + col;
        bf16_t* zg = Z + (size_t)((s_scan / RG_NC) * SEQ + (s_scan % RG_NC) * RG_L) * DIN + O_GR + ch;
        const float bav = ba[ch], bxv = bxp[ch], lac = -8.f * log1pf(expf(-lam[ch]));
        bf16x8 Br[8], Bi[8];
        {
            const bf16x8* wf = (const bf16x8*)RGW + (size_t)((hd * 4 + w4) * 2) * 8 * 64 + lane;
#pragma unroll
            for (int ks = 0; ks < 8; ++ks) { Br[ks] = wf[ks * 64]; Bi[ks] = wf[(8 + ks) * 64]; }
        }
        float h = PASS_B ? RGH[(size_t)s_scan * D + ch] : 0.f, P = 1.f;
        bf16_t cur[16];
#pragma unroll
        for (int k = 0; k < 16; ++k) cur[k] = zx[(size_t)k * DIN];
        for (int step = 0; step < RG_STEPS; ++step) {
            const int pb = step & 1;
            SLAS bf16_t* At = (SLAS bf16_t*)(base + pb * 8704); SLAS float* Ft = (SLAS float*)(base + 17408 + pb * 16896);
            bf16_t gg[16];
            if (PASS_B) {
#pragma unroll
                for (int i = 0; i < 16; ++i) gg[i] = zg[(size_t)(16 * step + i) * DIN];
            }
#pragma unroll
            for (int k = 0; k < 16; ++k) {
                const float x0 = bf2f(cur[k]);
                const float xc = cw0 * x3 + cw1 * x2 + cw2 * x1 + cw3 * x0 + cb;
                x3 = x2; x2 = x1; x1 = x0;
                const int row = (k & 3) + 8 * (k >> 2) + 4 * cs;
                At[row * 136 + cch] = (bf16_t)(pk2c(xc, 0.f) & 0xffffu); Ft[row * 132 + cch] = xc;
            }
            if (step + 1 < RG_STEPS) {
#pragma unroll
                for (int k = 0; k < 16; ++k) cur[k] = zx[(size_t)(16 * (step + 1) + k) * DIN];
            }
            __syncthreads();
            f32x16 accR, accI;
#pragma unroll
            for (int i = 0; i < 16; ++i) { accR[i] = 0.f; accI[i] = 0.f; }
#pragma unroll
            for (int ks = 0; ks < 8; ++ks) { const bf16x8 af = *(const SLAS bf16x8*)(At + col * 136 + 16 * ks + 8 * hf);
                accR = MFMA32(af, Br[ks], accR); accI = MFMA32(af, Bi[ks], accI); }
#pragma unroll
            for (int i = 0; i < 16; ++i) {
                const float xc = Ft[crow(i, hf) * 132 + w4 * 32 + col];
                const float r = sigm(accR[i] + bav), ig = sigm(accI[i] + bxv);
                const float la = r * lac, av = __expf(la), x = 2.f * la;
                const float m2 = -x * (1.f + x * (0.5f + x * (0.16666667f + x * (0.041666668f + x * (0.008333334f + x * 0.0013888889f)))));
                const float bb = __builtin_amdgcn_sqrtf(m2) * (ig * xc);
                h = av * h + bb;
                if (PASS_B) zg[(size_t)(16 * step + i) * DIN] = (bf16_t)(pk2c(h * bf2f(gg[i]), 0.f) & 0xffffu);
                else P *= av;
                if ((i & 3) == 3) __builtin_amdgcn_sched_barrier(0);
            }
        }
        if (!PASS_B) { RGP[(size_t)s_scan * D + ch] = P; RGS[(size_t)s_scan * D + ch] = h; }
        __syncthreads();
    }
}
__device__ __forceinline__ void rglru_carry(const float* RGP, const float* RGS, float* RGH, int idx) {
    const int b = idx / D, ch = idx % D; float H = 0.f;
#pragma unroll 8
    for (int c = 0; c < RG_NC; ++c) { const size_t o = (size_t)(b * RG_NC + c) * D + ch; RGH[o] = H; H = RGP[o] * H + RGS[o]; }
}

__device__ __forceinline__ size_t s5_idx(int g, int T, int row, int s) { return ((size_t)(g * 128 + (T >> 1) * 64 + (T & 1) * 32 + row)) * S5_NS + s; }
template <bool PASS_B>
__device__ __forceinline__ void s5_pass(bf16_t* Z, const float2* __restrict__ lamtab, const float* __restrict__ bbr, const float* __restrict__ bbi, const float* __restrict__ c_re, const float* __restrict__ c_im,
                                        const float* __restrict__ dd, float* S5S, const float* S5H, SLAS f32x2v* ltab  , int gw, int NGW, int lane) {
    const int col = lane & 31, hf = lane >> 5;
    for (int unit = gw; unit < S5_UNITS; unit += NGW) {
        const int g = unit & (NG - 1), sset = unit / NG;
        const int s = sset * 32 + col, b = s / S5_NC, c = s % S5_NC;
        bf16_t* zu = Z + ((size_t)b * SEQ + (size_t)c * S5_L) * DIN + O_U + g * GS;
        bf16x8 Ab[4];
#pragma unroll
        for (int T = 0; T < 4; ++T) { const float* src = ((T >> 1) ? bbi : bbr) + (size_t)(g * NP + 32 * (T & 1) + col) * GS + 8 * hf;
            Ab[T] = pack8(src[0], src[1], src[2], src[3], src[4], src[5], src[6], src[7]); }
        { const int e_hf = lane >> 5, e_tp = (lane >> 4) & 1, e_i = lane & 15; const float2 lv = lamtab[g * NP + 32 * e_tp + crow(e_i, e_hf)]; f32x2v lw = {lv.x, lv.y}; ltab[lane] = lw; }
        f32x16 h[4];
#pragma unroll
        for (int T = 0; T < 4; ++T)
#pragma unroll
            for (int i = 0; i < 16; ++i) h[T][i] = PASS_B ? S5H[s5_idx(g, T, crow(i, hf), s)] : 0.f;
        bf16x8 Ac[4][2], Adh, Adl;
        if (PASS_B) {
            const int hp = col & 15; const bool live = col < 16;
#pragma unroll
            for (int T = 0; T < 4; ++T)
#pragma unroll
                for (int sk = 0; sk < 2; ++sk) { float v[8];
#pragma unroll
                    for (int j = 0; j < 8; ++j) { const int p = 32 * (T & 1) + 16 * sk + 8 * (j >> 2) + 4 * hf + (j & 3);
                        const float cv = (T < 2) ? c_re[(size_t)(g * GS + hp) * NP + p] : -c_im[(size_t)(g * GS + hp) * NP + p]; v[j] = live ? cv : 0.f; }
                    Ac[T][sk] = pack8(v[0], v[1], v[2], v[3], v[4], v[5], v[6], v[7]); }
            const float dv = dd[g * GS + hp]; const float dhi = __uint_as_float(pk2c(dv, 0.f) << 16), dlo = dv - dhi;
            float vh[8], vl[8];
#pragma unroll
            for (int j = 0; j < 8; ++j) { const bool on = live && (hp == 8 * hf + j); vh[j] = on ? dhi : 0.f; vl[j] = on ? dlo : 0.f; }
            Adh = pack8(vh[0], vh[1], vh[2], vh[3], vh[4], vh[5], vh[6], vh[7]); Adl = pack8(vl[0], vl[1], vl[2], vl[3], vl[4], vl[5], vl[6], vl[7]);
        }
        bf16x8 u = *(const bf16x8*)(zu + 8 * hf);
        for (int step = 0; step < S5_L; ++step) {
            bf16x8 un = u;
            if (step + 1 < S5_L) un = *(const bf16x8*)(zu + (size_t)(step + 1) * DIN + 8 * hf);
            asm volatile("" ::: "memory");
#pragma unroll
            for (int tp = 0; tp < 2; ++tp) { f32x16 tr, ti;
#pragma unroll
                for (int i = 0; i < 16; i += 2) { const f32x4 l2 = *(const SLAS f32x4*)(ltab + (hf * 2 + tp) * 16 + i);
                    tr[i] = l2[0] * h[tp][i] - l2[1] * h[tp + 2][i]; ti[i] = l2[0] * h[tp + 2][i] + l2[1] * h[tp][i];
                    tr[i + 1] = l2[2] * h[tp][i + 1] - l2[3] * h[tp + 2][i + 1]; ti[i + 1] = l2[2] * h[tp + 2][i + 1] + l2[3] * h[tp][i + 1]; }
                h[tp] = MFMA32(Ab[tp], u, tr); h[tp + 2] = MFMA32(Ab[tp + 2], u, ti);
                __builtin_amdgcn_sched_barrier(0); }
            if (PASS_B) {
                f32x16 y;
#pragma unroll
                for (int i = 0; i < 16; ++i) y[i] = 0.f;
                y = MFMA32(Adh, u, y); y = MFMA32(Adl, u, y);
#pragma unroll
                for (int T = 0; T < 4; ++T)
#pragma unroll
                    for (int sk = 0; sk < 2; ++sk) { const bf16x8 xb = pack8(h[T][8 * sk], h[T][8 * sk + 1], h[T][8 * sk + 2], h[T][8 * sk + 3], h[T][8 * sk + 4], h[T][8 * sk + 5], h[T][8 * sk + 6], h[T][8 * sk + 7]);
                        y = MFMA32(Ac[T][sk], xb, y); }
                u32x2 o0, o1; o0.x = pk2c(gelu_t(y[0]), gelu_t(y[1])); o0.y = pk2c(gelu_t(y[2]), gelu_t(y[3])); o1.x = pk2c(gelu_t(y[4]), gelu_t(y[5])); o1.y = pk2c(gelu_t(y[6]), gelu_t(y[7]));
                bf16_t* zo = zu + (size_t)step * DIN + 4 * hf;
                *(u32x2*)zo = o0; *(u32x2*)(zo + 8) = o1;
            }
            u = un;
        }
        if (!PASS_B) {
#pragma unroll
            for (int T = 0; T < 4; ++T)
#pragma unroll
                for (int i = 0; i < 16; ++i) S5S[s5_idx(g, T, crow(i, hf), s)] = h[T][i];
        }
    }
}
__device__ __forceinline__ void s5_carry(const float2* __restrict__ lamtab, const float* S5S, float* S5H, int idx) {
    const int b = idx / (NG * NP), gp = idx % (NG * NP), g = gp / NP, p = gp % NP;
    float2 L = lamtab[gp];
#pragma unroll
    for (int k = 0; k < 5; ++k) { const float nr = L.x * L.x - L.y * L.y, ni = 2.f * L.x * L.y; L.x = nr; L.y = ni; }
    static_assert(S5_L == 32, "lambda^L by 5 squarings");
    const size_t ore = ((size_t)(g * 128 + p)) * S5_NS + (size_t)b * S5_NC, oim = ore + (size_t)64 * S5_NS;
    const f32x4* sre = (const f32x4*)(S5S + ore); const f32x4* sim = (const f32x4*)(S5S + oim);
    f32x4* hre = (f32x4*)(S5H + ore); f32x4* him = (f32x4*)(S5H + oim);
    float Hr = 0.f, Hi = 0.f;
#pragma unroll 4
    for (int c4 = 0; c4 < S5_NC / 4; ++c4) {
        const f32x4 vr = sre[c4], vi = sim[c4]; f32x4 orr, oi;
#pragma unroll
        for (int j = 0; j < 4; ++j) { orr[j] = Hr; oi[j] = Hi; const float nr = L.x * Hr - L.y * Hi + vr[j], ni = L.x * Hi + L.y * Hr + vi[j]; Hr = nr; Hi = ni; }
        hre[c4] = orr; him[c4] = oi;
    }
}
}

namespace cg = cooperative_groups;
#define LAS __attribute__((address_space(3)))
constexpr int NWAVES = 8, NTHREADS = NWAVES * 64;
constexpr int LDS_BYTES = 147456;
typedef float f32x4 __attribute__((ext_vector_type(4)));
typedef unsigned u32x4 __attribute__((ext_vector_type(4)));
typedef unsigned u32x2 __attribute__((ext_vector_type(2)));
struct Args { const float* in[N_IN]; float* out; unsigned char* ws; int ph_lo, ph_hi; };
static_assert(sizeof(Args) == (N_IN + 2) * 8 + 8, "Args has no padding");

__device__ __forceinline__ unsigned pk2(float lo, float hi) { return pg8::cvt_pk_bf16(lo, hi); }
__device__ __forceinline__ int rowmap(int mode, int n) { return mode == 0 ? n : ((n >> 7) * 256 + (mode == 2 ? 128 : 0) + (n & 127)); }
__device__ __forceinline__ void p0_transpose_item(const float* __restrict__ W, int K, int N, bf16_t* __restrict__ WT, int mode, LAS float* scr, int item, int lane) {
    const int nblk = N / 32, kb = item / nblk, nb = item % nblk, k0 = 64 * kb, n0 = 32 * nb;
#pragma unroll 8
    for (int i = 0; i < 32; ++i) { const int kk = 2 * i + (lane >> 5); scr[kk * 33 + (lane & 31)] = W[(size_t)(k0 + kk) * N + n0 + (lane & 31)]; }
    asm volatile("s_waitcnt lgkmcnt(0)" ::: "memory");
    const int c = lane & 7, rbase = rowmap(mode, n0);
#pragma unroll
    for (int j = 0; j < 4; ++j) { const int n = (lane >> 3) + 8 * j; const LAS float* s = scr + (8 * c) * 33 + n;
        u32x4 o; o.x = pk2(s[0 * 33], s[1 * 33]); o.y = pk2(s[2 * 33], s[3 * 33]); o.z = pk2(s[4 * 33], s[5 * 33]); o.w = pk2(s[6 * 33], s[7 * 33]);
        *(u32x4*)(WT + (size_t)(rbase + n) * K + k0 + 8 * c) = o; }
    asm volatile("s_waitcnt lgkmcnt(0)" ::: "memory");
}
__device__ __forceinline__ float wave_sum(float v) {
#pragma unroll
    for (int o = 1; o < 64; o <<= 1) v += __shfl_xor(v, o);
    return v;
}
__device__ __forceinline__ void ln_row(float* xrow, const float* __restrict__ g, const float* __restrict__ bt, bf16_t* orow, int lane) {
    f32x4* xr = (f32x4*)xrow + lane;
    f32x4 v[8]; float s = 0.f;
#pragma unroll
    for (int j = 0; j < 8; ++j) { v[j] = xr[64 * j]; s += (v[j].x + v[j].y) + (v[j].z + v[j].w); }
    const float mean = wave_sum(s) * (1.f / D); float s2 = 0.f;
#pragma unroll
    for (int j = 0; j < 8; ++j) { v[j] = v[j] - mean; s2 += (v[j].x * v[j].x + v[j].y * v[j].y) + (v[j].z * v[j].z + v[j].w * v[j].w); }
    const float rstd = rsqrtf(wave_sum(s2) * (1.f / D) + LN_EPS);
#pragma unroll
    for (int j = 0; j < 8; ++j) { const f32x4 gv = *((const f32x4*)g + lane + 64 * j), bv = *((const f32x4*)bt + lane + 64 * j);
        const f32x4 y = v[j] * rstd * gv + bv; xr[64 * j] = y;
        if (orow) { u32x2 w; w.x = pk2(y.x, y.y); w.y = pk2(y.z, y.w); *((u32x2*)orow + lane + 64 * j) = w; } }
}


#define XB_TMO      128
#define XB_XCNT(j)  (256  + 64 * (j))
#define XB_XSUB(j)  (1280 + 64 * (j))
#define XB_XGEN(j)  (2304 + 64 * (j))
#define XB_TOP      3328
#define XB_TOPGEN   3392
#define XCD_BAR_WORDS 3456
#define XB_SPIN_CAP (1u << 18)
__device__ __forceinline__ unsigned xb_ld(unsigned* p)              { return __hip_atomic_load(p, __ATOMIC_RELAXED, __HIP_MEMORY_SCOPE_AGENT); }
__device__ __forceinline__ unsigned xb_add(unsigned* p, unsigned v) { return __hip_atomic_fetch_add(p, v, __ATOMIC_RELAXED, __HIP_MEMORY_SCOPE_AGENT); }
__device__ __forceinline__ unsigned xb_xcc_id() { return (unsigned)__builtin_amdgcn_s_getreg((3 << 11) | 20) & 0xFu; }
#define XB_SPIN(cond, bar) do { unsigned _sp = 0; while (cond) { __builtin_amdgcn_s_sleep(1); \
    if ((++_sp & 255u) == 0u) { if (xb_ld(&(bar)[XB_TMO])) break; if (_sp > XB_SPIN_CAP) { atomicAdd(&(bar)[XB_TMO], 1u); break; } } } } while (0)
struct XcdBarrier { unsigned* bar; unsigned x; volatile LAS unsigned* st; };
__device__ __forceinline__ XcdBarrier xcd_barrier_post(unsigned* bar, volatile LAS unsigned* st) {
    XcdBarrier b; b.bar = bar; b.x = xb_xcc_id(); b.st = st;
    if (threadIdx.x == 0) (void)xb_add(&bar[XB_XCNT(b.x)], 1u);
    return b;
}
__device__ __forceinline__ void xcd_barrier_complete(unsigned* bar, unsigned x, unsigned& nloc, unsigned& nx) {
    const unsigned G = gridDim.x * gridDim.y * gridDim.z;
    unsigned sum, cnt, mine, sp = 0u;
    for (;;) {
        sum = 0u; cnt = 0u; mine = 0u;
#pragma unroll
        for (unsigned j = 0; j < 16; ++j) { const unsigned c = xb_ld(&bar[XB_XCNT(j)]); sum += c; cnt += (c > 0u) ? 1u : 0u; mine = (j == x) ? c : mine; }
        if (sum == G) break;
        __builtin_amdgcn_s_sleep(1);
        if ((++sp & 255u) == 0u) { if (xb_ld(&bar[XB_TMO])) break; if (sp > XB_SPIN_CAP) { atomicAdd(&bar[XB_TMO], 1u); break; } }
    }
    nloc = mine > 0u ? mine : 1u; nx = cnt > 0u ? cnt : 1u;
}
__device__ __forceinline__ void xcd_barrier(const XcdBarrier& b) {
    asm volatile("s_waitcnt vmcnt(0)" ::: "memory");
    __syncthreads();
    if (threadIdx.x == 0) {
        unsigned* bar = b.bar;
        __builtin_amdgcn_s_waitcnt(0);
        unsigned nloc = b.st[0], nx = b.st[1];
        if (nloc == 0u) { xcd_barrier_complete(bar, b.x, nloc, nx); b.st[0] = nloc; b.st[1] = nx; }
        const unsigned old = xb_add(&bar[XB_XSUB(b.x)], 1u);
        const unsigned gen = old / nloc;
        if (old + 1u == (gen + 1u) * nloc) {
            __builtin_amdgcn_fence(__ATOMIC_RELEASE, "agent");
            asm volatile("s_waitcnt vmcnt(0)" ::: "memory");
            const unsigned og = xb_add(&bar[XB_TOP], 1u);
            const unsigned tg = og / nx;
            if (og + 1u == (tg + 1u) * nx) xb_add(&bar[XB_TOPGEN], 1u);
            else XB_SPIN(xb_ld(&bar[XB_TOPGEN]) == tg, bar);
            __builtin_amdgcn_fence(__ATOMIC_ACQUIRE, "agent");
            xb_add(&bar[XB_XGEN(b.x)], 1u);
            asm volatile("s_waitcnt vmcnt(0)" ::: "memory");
        } else {
            XB_SPIN(xb_ld(&bar[XB_XGEN(b.x)]) == gen, bar);
            __builtin_amdgcn_fence(__ATOMIC_ACQUIRE, "agent");
            asm volatile("s_waitcnt vmcnt(0)" ::: "memory");
        }
    }
    __syncthreads();
}

__global__ void __launch_bounds__(NTHREADS, 2) mk_fwd(Args a) {
    extern __shared__ __attribute__((aligned(16))) unsigned char lds_raw[];
    LAS unsigned char* lds = (LAS unsigned char*)lds_raw;
    cg::grid_group grid = cg::this_grid();
    const int tid = threadIdx.x, lane = tid & 63, wave = __builtin_amdgcn_readfirstlane(tid >> 6);
    const int G = gridDim.x, bx = blockIdx.x;
    const int gw = bx * NWAVES + wave, NGW = G * NWAVES;
    unsigned char* ws = a.ws;
    bf16_t *Wt_in = (bf16_t*)(ws + WS_WIN), *Wt_a = (bf16_t*)(ws + WS_WA), *Wt_glu = (bf16_t*)(ws + WS_WGLU), *Wt_out = (bf16_t*)(ws + WS_WOUT), *Wt_up = (bf16_t*)(ws + WS_WUP), *Wt_down = (bf16_t*)(ws + WS_WDOWN);
    bf16_t *X1B = (bf16_t*)(ws + WS_X1B), *Z = (bf16_t*)(ws + WS_Z), *HMID = (bf16_t*)(ws + WS_Z), *XB = (bf16_t*)a.out;
    const int lo = a.ph_lo, hi = a.ph_hi;
#define IN(k) (lo <= (k) && (k) < hi)
    volatile LAS unsigned* MISC = (volatile LAS unsigned*)(lds + LDS_BYTES - 64);
    if (tid < 16) MISC[tid] = 0u;
    __syncthreads();
    XcdBarrier xbar = xcd_barrier_post((unsigned*)(ws + WS_CTL), MISC);
#ifndef MK_CG_SEAMS
#define MK_CG_SEAMS 1
#endif
#define SEAM(k) do { if (IN(k) && IN((k) + 1)) { if ((k) < MK_CG_SEAMS) grid.sync(); else xcd_barrier(xbar); } } while (0)

    if (IN(0)) {
        LAS float* scr = (LAS float*)(lds + wave * 16384);
        constexpr int I_IN = (D / 64) * (DIN / 32), I_A = (D / 64) * (D / 32), I_GL = (DSSM / 64) * (D / 32), I_UP = (D / 64) * (DFF / 32), I_DN = (DFF / 64) * (D / 32);
        constexpr int NITEMS = I_IN + 2 * I_A + 2 * I_GL + I_UP + I_DN;
        for (int it = gw; it < NITEMS; it += NGW) {
            int r = it;
            if (r < I_IN) { p0_transpose_item(a.in[I_WIN], D, DIN, Wt_in, 0, scr, r, lane); continue; } r -= I_IN;
            if (r < I_A) { p0_transpose_item(a.in[I_WAOUT], D, D, Wt_a, 0, scr, r, lane); continue; } r -= I_A;
            if (r < I_GL) { p0_transpose_item(a.in[I_GLUW], DSSM, D, Wt_glu, 1, scr, r, lane); continue; } r -= I_GL;
            if (r < I_GL) { p0_transpose_item(a.in[I_GLUV], DSSM, D, Wt_glu, 2, scr, r, lane); continue; } r -= I_GL;
            if (r < I_A) { p0_transpose_item(a.in[I_WOUT], D, D, Wt_out, 0, scr, r, lane); continue; } r -= I_A;
            if (r < I_UP) { p0_transpose_item(a.in[I_WUP], D, DFF, Wt_up, 0, scr, r, lane); continue; } r -= I_UP;
            p0_transpose_item(a.in[I_WDOWN], DFF, D, Wt_down, 0, scr, r, lane);
        }
        {
            const float* x = a.in[I_X]; const size_t n8 = (size_t)M * D / 8;
            for (size_t i = (size_t)bx * NTHREADS + tid; i < n8; i += (size_t)G * NTHREADS) {
                const f32x4 v0 = *((const f32x4*)x + 2 * i), v1 = *((const f32x4*)x + 2 * i + 1);
                u32x4 w; w.x = pk2(v0.x, v0.y); w.y = pk2(v0.z, v0.w); w.z = pk2(v1.x, v1.y); w.w = pk2(v1.z, v1.w);
                *((u32x4*)XB + i) = w; }
        }
        for (int idx = bx * NTHREADS + tid; idx < 16 * 4 * 2 * 8 * 64; idx += G * NTHREADS) scan::rglru_pack_weights(a.in[I_WA], a.in[I_WX], (bf16_t*)(ws + WS_RGW), idx);
        {
            const int idx = bx * NTHREADS + tid;
            if (idx < NG * NP) {
                float2* lam = (float2*)(ws + WS_S5LAM); float* bbr = (float*)(ws + WS_S5BBR); float* bbi = (float*)(ws + WS_S5BBI);
                const int g = idx / NP;
                const double dt = exp((double)a.in[I_LOGDT][g]);
                const double lr = fmin((double)a.in[I_ARE][idx], -1e-4), li = (double)a.in[I_AIM][idx];
                const double mag = exp(lr * dt), lbr = mag * cos(li * dt), lbi = mag * sin(li * dt);
                const double zr = lbr - 1.0, zi = lbi, den = lr * lr + li * li;
                const double fr = (zr * lr + zi * li) / den, fi = (zi * lr - zr * li) / den;
                lam[idx] = make_float2((float)lbr, (float)lbi);
                for (int h = 0; h < GS; ++h) { const double br = a.in[I_BRE][idx * GS + h], bi = a.in[I_BIM][idx * GS + h];
                    bbr[idx * GS + h] = (float)(fr * br - fi * bi); bbi[idx * GS + h] = (float)(fr * bi + fi * br); }
            }
        }
        __syncthreads();
    }
    SEAM(0);
    if (IN(1)) { pg8::Gemm g{XB, D, Wt_in, D, M, DIN, D}; pg8::StaticOrder S; S.init(M, DIN, G, bx); pg8::gemm_phase(lds, g, S, pg8::EpiZ{Z}); }
    SEAM(1);
    {
        const float2* lamtab = (const float2*)(ws + WS_S5LAM); const float* bbr = (const float*)(ws + WS_S5BBR); const float* bbi = (const float*)(ws + WS_S5BBI);
        const bf16_t* RGW = (const bf16_t*)(ws + WS_RGW); float *RGP = (float*)(ws + scan::WS_RGP), *RGS = (float*)(ws + scan::WS_RGS), *RGH = (float*)(ws + scan::WS_RGH), *S5S = (float*)(ws + scan::WS_S5S), *S5H = (float*)(ws + scan::WS_S5H);
        if (IN(2)) {
            scan::rglru_pass<false>(lds, Z, a.in[I_CONVW], a.in[I_CONVB], RGW, a.in[I_BA], a.in[I_BX], a.in[I_LAM], RGP, RGS, RGH, bx, G);
            scan::s5_pass<false>(Z, lamtab, bbr, bbi, a.in[I_CRE], a.in[I_CIM], a.in[I_SD], S5S, S5H, (LAS scan::f32x2v*)(lds + 114688 + wave * 512), gw, NGW, lane);
        }
        SEAM(2);
        if (IN(3)) {
            if (tid < 48) for (int idx = bx * 48 + tid; idx < NB * NG * NP + NB * D; idx += G * 48) {
                if (idx < NB * NG * NP) scan::s5_carry(lamtab, S5S, S5H, idx); else scan::rglru_carry(RGP, RGS, RGH, idx - NB * NG * NP); }
        }
        SEAM(3);
        if (IN(4)) {
            scan::rglru_pass<true>(lds, Z, a.in[I_CONVW], a.in[I_CONVB], RGW, a.in[I_BA], a.in[I_BX], a.in[I_LAM], RGP, RGS, RGH, bx, G);
            scan::s5_pass<true>(Z, lamtab, bbr, bbi, a.in[I_CRE], a.in[I_CIM], a.in[I_SD], S5S, S5H, (LAS scan::f32x2v*)(lds + 114688 + wave * 512), gw, NGW, lane);
        }
        SEAM(4);
    }
    if (IN(5)) { pg8::Gemm g{Z + O_U, DIN, Wt_glu, DSSM, M, 2 * D, DSSM}; pg8::StaticOrder S; S.init(M, 2 * D, G, bx); pg8::gemm_phase(lds, g, S, pg8::EpiGlu{Z}); }
    SEAM(5);
    if (IN(6)) { pg8::Gemm g{Z + O_GR, DIN, Wt_a, D, M, D, D}; pg8::StaticOrder S; S.init(M, D, G, bx); pg8::gemm_phase(lds, g, S, pg8::EpiMix{Z}); }
    SEAM(6);
    if (IN(7)) { pg8::Gemm g{Z + O_GA, DIN, Wt_out, D, M, D, D}; pg8::StaticOrder S; S.init(M, D, G, bx); pg8::gemm_phase(lds, g, S, pg8::EpiR1{a.in[I_X], a.out}); }
    SEAM(7);
    if (IN(8)) { for (int m = gw; m < M; m += NGW) ln_row(a.out + (size_t)m * D, a.in[I_LN1G], a.in[I_LN1B], X1B + (size_t)m * D, lane); }
    SEAM(8);
    if (IN(9)) { pg8::Gemm g{X1B, D, Wt_up, D, M, DFF, D}; pg8::StaticOrder S; S.init(M, DFF, G, bx); pg8::gemm_phase(lds, g, S, pg8::EpiUp{HMID, a.in[I_BUP]}); }
    SEAM(9);
    if (IN(10)) { pg8::Gemm g{HMID, DFF, Wt_down, DFF, M, D, DFF}; pg8::StaticOrder S; S.init(M, D, G, bx); pg8::gemm_phase(lds, g, S, pg8::EpiR2{a.out, a.in[I_BDOWN]}); }
    SEAM(10);
    if (IN(11)) { for (int m = gw; m < M; m += NGW) ln_row(a.out + (size_t)m * D, a.in[I_LN2G], a.in[I_LN2B], nullptr, lane); }
#undef IN
#undef SEAM
}

#ifndef MK_SCAN_NAIVE
#define MK_SCAN_NAIVE 0
#endif
static hipError_t launch_mk(Args& a, int lo, int hi, int grid, hipStream_t stream) {
    a.ph_lo = lo; a.ph_hi = hi; void* args[] = {&a};
    return hipLaunchCooperativeKernel((const void*)mk_fwd, dim3(grid), dim3(NTHREADS), args, LDS_BYTES, stream);
}
extern "C" void kernel_launch(void* const* d_in, const int* in_sizes, int n_in, void* d_out, int out_size, void* d_ws, size_t ws_size, hipStream_t stream) {
    static int grid = 0;
    if (grid == 0) {
        if (n_in != N_IN || out_size != M * D || ws_size < WS_END) { fprintf(stderr, "kernel_launch: unexpected shapes (n_in %d out %d ws %zu)\n", n_in, out_size, ws_size); grid = -1; return; }
        int dev = 0, cus = 0, per_cu = 0;
        if (hipGetDevice(&dev) != hipSuccess || hipDeviceGetAttribute(&cus, hipDeviceAttributeMultiprocessorCount, dev) != hipSuccess) { grid = -1; return; }
        if (hipFuncSetAttribute((const void*)mk_fwd, hipFuncAttributeMaxDynamicSharedMemorySize, LDS_BYTES) != hipSuccess) { fprintf(stderr, "kernel_launch: hipFuncSetAttribute failed\n"); grid = -1; return; }
        if (hipOccupancyMaxActiveBlocksPerMultiprocessor(&per_cu, (const void*)mk_fwd, NTHREADS, LDS_BYTES) != hipSuccess || per_cu < 1) { fprintf(stderr, "kernel_launch: occupancy query says %d\n", per_cu); grid = -1; return; }
        grid = cus;
#if MK_SCAN_NAIVE
        (void)hipFuncSetAttribute((const void*)nv::k_rglru, hipFuncAttributeMaxDynamicSharedMemorySize, (2 * HD * HD + HD) * 4);
#endif
    }
    if (grid < 0) return;
    Args a{};
    for (int i = 0; i < N_IN; ++i) a.in[i] = (const float*)d_in[i];
    a.out = (float*)d_out; a.ws = (unsigned char*)d_ws;
    hipError_t e;
    if (hipMemsetAsync((char*)d_ws + WS_CTL, 0, 16384, stream) != hipSuccess) { fprintf(stderr, "kernel_launch: memset of the barrier words failed\n"); return; }
#if MK_SCAN_NAIVE
    unsigned char* ws = (unsigned char*)d_ws; bf16_t* Z = (bf16_t*)(ws + WS_Z);
    e = launch_mk(a, 0, 2, grid, stream);
    nv::k_rglru<<<NB * HEADS, 128, (2 * HD * HD + HD) * 4, stream>>>(Z, a.in[I_CONVW], a.in[I_CONVB], a.in[I_WA], a.in[I_BA], a.in[I_WX], a.in[I_BX], a.in[I_LAM]);
    nv::k_s5<<<NB * NG, 64, 0, stream>>>(Z, (const float2*)(ws + WS_S5LAM), (const float*)(ws + WS_S5BBR), (const float*)(ws + WS_S5BBI), a.in[I_CRE], a.in[I_CIM], a.in[I_SD]);
    if (e == hipSuccess) e = launch_mk(a, 5, 12, grid, stream);
#else
    e = launch_mk(a, 0, 12, grid, stream);
#endif
    if (e != hipSuccess) fprintf(stderr, "kernel_launch: cooperative launch failed: %s (grid %d)\n", hipGetErrorString(e), grid);
}
```

```cpp
#include <hip/hip_runtime.h>
#include <hip/hip_cooperative_groups.h>
#include <cstdio>
#include <cstdint>

typedef unsigned short bf16_t;
constexpr int NB = 2, SEQ = 8192, M = NB * SEQ, D = 2048, HEADS = 16, HD = 128, DSSM = 1024, NG = 64, GS = 16, NP = 64, DFF = 8192, DIN = 9216;
constexpr int O_XR = 0, O_GR = 2048, O_U = 4096, O_GA = 5120, O_GB = 7168;
constexpr float ALPHA = 1.189207115002721f;
constexpr float LN_EPS = 1e-5f;
enum { I_X = 0, I_WIN, I_CONVW, I_CONVB, I_WA, I_BA, I_WX, I_BX, I_LAM, I_WAOUT, I_ARE, I_AIM, I_LOGDT, I_BRE, I_BIM, I_CRE, I_CIM, I_SD, I_GLUW, I_GLUV, I_WOUT,
       I_LN1G, I_LN1B, I_WUP, I_BUP, I_WDOWN, I_BDOWN, I_LN2G, I_LN2B, N_IN };

constexpr size_t MiB = 1u << 20;
constexpr size_t WS_CTL = 0;
constexpr size_t WS_S5LAM = 1 * MiB;
constexpr size_t WS_S5BBR = WS_S5LAM + 64 * 1024;
constexpr size_t WS_S5BBI = WS_S5BBR + 256 * 1024;
constexpr size_t WS_WIN = 2 * MiB;
constexpr size_t WS_WA = WS_WIN + 36 * MiB;
constexpr size_t WS_WGLU = WS_WA + 8 * MiB;
constexpr size_t WS_WOUT = WS_WGLU + 8 * MiB;
constexpr size_t WS_WUP = WS_WOUT + 8 * MiB;
constexpr size_t WS_WDOWN = WS_WUP + 32 * MiB;
constexpr size_t WS_X1B = WS_WDOWN + 32 * MiB;
constexpr size_t WS_Z = WS_X1B + 64 * MiB;
constexpr size_t WS_RGW = WS_Z + 288 * MiB;
constexpr size_t WS_END = WS_RGW + 1 * MiB;

__device__ __forceinline__ bf16_t f2bf(float f) { unsigned u = __float_as_uint(f); u += 0x7fffu + ((u >> 16) & 1u); return (bf16_t)(u >> 16); }
__device__ __forceinline__ float bf2f(bf16_t b) { return __uint_as_float(((unsigned)b) << 16); }
__device__ __forceinline__ float sigmoid_f(float x) { return 1.f / (1.f + __expf(-x)); }
__device__ __forceinline__ float gelu_tanh(float x) { const float u = 1.5957691216057308f * (x + 0.044715f * x * x * x); return x * sigmoid_f(u); }

namespace nv {
__device__ __forceinline__ int rowmap(int mode, int n) { return mode == 0 ? n : ((n >> 7) * 256 + (mode == 2 ? 128 : 0) + (n & 127)); }
__global__ void k_transpose(const float* __restrict__ W, int K, int N, bf16_t* __restrict__ Wt, int mode) {
    __shared__ float tile[32][33];
    const int n0 = blockIdx.x * 32, k0 = blockIdx.y * 32;
    for (int i = threadIdx.y; i < 32; i += 8) tile[i][threadIdx.x] = W[(size_t)(k0 + i) * N + n0 + threadIdx.x];
    __syncthreads();
    for (int i = threadIdx.y; i < 32; i += 8) { const int row = rowmap(mode, n0 + i); Wt[(size_t)row * K + k0 + threadIdx.x] = f2bf(tile[threadIdx.x][i]); }
}
__global__ void k_cvt(const float* __restrict__ x, bf16_t* __restrict__ xb, size_t n) {
    for (size_t i = (size_t)blockIdx.x * blockDim.x + threadIdx.x; i < n; i += (size_t)gridDim.x * blockDim.x) xb[i] = f2bf(x[i]);
}
__global__ void k_s5_params(const float* a_re, const float* a_im, const float* log_dt, const float* b_re, const float* b_im, float2* lam, float* bbr, float* bbi) {
    const int idx = blockIdx.x * blockDim.x + threadIdx.x; if (idx >= NG * NP) return;
    const int g = idx / NP;
    const double dt = exp((double)log_dt[g]);
    const double lr = fmin((double)a_re[idx], -1e-4), li = (double)a_im[idx];
    const double mag = exp(lr * dt), lbr = mag * cos(li * dt), lbi = mag * sin(li * dt);
    const double zr = lbr - 1.0, zi = lbi, den = lr * lr + li * li;
    const double fr = (zr * lr + zi * li) / den, fi = (zi * lr - zr * li) / den;
    lam[idx] = make_float2((float)lbr, (float)lbi);
    for (int h = 0; h < GS; ++h) { const double br = b_re[idx * GS + h], bi = b_im[idx * GS + h];
        bbr[idx * GS + h] = (float)(fr * br - fi * bi); bbi[idx * GS + h] = (float)(fr * bi + fi * br); }
}
template <class Epi> __global__ void __launch_bounds__(256) k_gemm(const bf16_t* __restrict__ A, int lda, const bf16_t* __restrict__ Bt, int ldb, int K, Epi E) {
    __shared__ float As[16][68], Bs[16][68];
    const int tid = threadIdx.x, tx = tid & 15, ty = tid >> 4, m0 = blockIdx.y * 64, n0 = blockIdx.x * 64;
    float acc[4][4];
#pragma unroll
    for (int i = 0; i < 4; ++i)
#pragma unroll
        for (int j = 0; j < 4; ++j) acc[i][j] = 0.f;
    const int lr = tid >> 2, lk = (tid & 3) * 4;
    for (int k0 = 0; k0 < K; k0 += 16) {
        const ushort4 av = *(const ushort4*)(A + (size_t)(m0 + lr) * lda + k0 + lk);
        const ushort4 bv = *(const ushort4*)(Bt + (size_t)(n0 + lr) * ldb + k0 + lk);
        As[lk + 0][lr] = bf2f(av.x); As[lk + 1][lr] = bf2f(av.y); As[lk + 2][lr] = bf2f(av.z); As[lk + 3][lr] = bf2f(av.w);
        Bs[lk + 0][lr] = bf2f(bv.x); Bs[lk + 1][lr] = bf2f(bv.y); Bs[lk + 2][lr] = bf2f(bv.z); Bs[lk + 3][lr] = bf2f(bv.w);
        __syncthreads();
#pragma unroll
        for (int k = 0; k < 16; ++k) {
            const float4 a = *(const float4*)&As[k][ty * 4], b = *(const float4*)&Bs[k][tx * 4];
            const float aa[4] = {a.x, a.y, a.z, a.w}, bb[4] = {b.x, b.y, b.z, b.w};
#pragma unroll
            for (int i = 0; i < 4; ++i)
#pragma unroll
                for (int j = 0; j < 4; ++j) acc[i][j] += aa[i] * bb[j];
        }
        __syncthreads();
    }
#pragma unroll
    for (int i = 0; i < 4; ++i)
#pragma unroll
        for (int j = 0; j < 4; ++j) E(m0 + ty * 4 + i, n0 + tx * 4 + j, acc[i][j]);
}
__global__ void __launch_bounds__(256) k_glu(const bf16_t* __restrict__ A, int lda, const bf16_t* __restrict__ Bt, int K, bf16_t* Z) {
    __shared__ float As[16][68], Bw[16][68], Bv[16][68];
    const int tid = threadIdx.x, tx = tid & 15, ty = tid >> 4, m0 = blockIdx.y * 64, n0 = blockIdx.x * 64;
    float aw[4][4], avv[4][4];
#pragma unroll
    for (int i = 0; i < 4; ++i)
#pragma unroll
        for (int j = 0; j < 4; ++j) { aw[i][j] = 0.f; avv[i][j] = 0.f; }
    const int lr = tid >> 2, lk = (tid & 3) * 4;
    const int rw = rowmap(1, n0 + lr), rv = rowmap(2, n0 + lr);
    for (int k0 = 0; k0 < K; k0 += 16) {
        const ushort4 a4 = *(const ushort4*)(A + (size_t)(m0 + lr) * lda + k0 + lk);
        const ushort4 w4 = *(const ushort4*)(Bt + (size_t)rw * K + k0 + lk);
        const ushort4 v4 = *(const ushort4*)(Bt + (size_t)rv * K + k0 + lk);
        As[lk + 0][lr] = bf2f(a4.x); As[lk + 1][lr] = bf2f(a4.y); As[lk + 2][lr] = bf2f(a4.z); As[lk + 3][lr] = bf2f(a4.w);
        Bw[lk + 0][lr] = bf2f(w4.x); Bw[lk + 1][lr] = bf2f(w4.y); Bw[lk + 2][lr] = bf2f(w4.z); Bw[lk + 3][lr] = bf2f(w4.w);
        Bv[lk + 0][lr] = bf2f(v4.x); Bv[lk + 1][lr] = bf2f(v4.y); Bv[lk + 2][lr] = bf2f(v4.z); Bv[lk + 3][lr] = bf2f(v4.w);
        __syncthreads();
#pragma unroll
        for (int k = 0; k < 16; ++k) {
            const float4 a = *(const float4*)&As[k][ty * 4], w = *(const float4*)&Bw[k][tx * 4], v = *(const float4*)&Bv[k][tx * 4];
            const float aa[4] = {a.x, a.y, a.z, a.w}, ww[4] = {w.x, w.y, w.z, w.w}, vv[4] = {v.x, v.y, v.z, v.w};
#pragma unroll
            for (int i = 0; i < 4; ++i)
#pragma unroll
                for (int j = 0; j < 4; ++j) { aw[i][j] += aa[i] * ww[j]; avv[i][j] += aa[i] * vv[j]; }
        }
        __syncthreads();
    }
#pragma unroll
    for (int i = 0; i < 4; ++i)
#pragma unroll
        for (int j = 0; j < 4; ++j) { const int row = m0 + ty * 4 + i, col = n0 + tx * 4 + j; bf16_t* p = Z + (size_t)row * DIN + O_GB + col;
            *p = f2bf(aw[i][j] * sigmoid_f(avv[i][j]) * bf2f(*p)); }
}
__global__ void __launch_bounds__(128) k_rglru(bf16_t* Z, const float* conv_w, const float* conv_b, const float* wa, const float* ba, const float* wx, const float* bx, const float* lam) {
    extern __shared__ float sm[];
    float* s_wa = sm; float* s_wx = sm + HD * HD; float* s_xc = sm + 2 * HD * HD;
    const int b = blockIdx.x / HEADS, hd = blockIdx.x % HEADS, j = threadIdx.x, ch = hd * HD + j;
    for (int i = j; i < HD * HD; i += 128) { s_wa[i] = wa[(size_t)hd * HD * HD + i]; s_wx[i] = wx[(size_t)hd * HD * HD + i]; }
    const float cw0 = conv_w[0 * D + ch], cw1 = conv_w[1 * D + ch], cw2 = conv_w[2 * D + ch], cw3 = conv_w[3 * D + ch], cb = conv_b[ch];
    const float bav = ba[ch], bxv = bx[ch];
    const float lac = -8.f * log1pf(expf(-lam[ch]));
    float x1 = 0.f, x2 = 0.f, x3 = 0.f, h = 0.f;
    __syncthreads();
    bf16_t* zr = Z + (size_t)b * SEQ * DIN;
    for (int t = 0; t < SEQ; ++t) {
        const float x0 = bf2f(zr[(size_t)t * DIN + O_XR + ch]);
        const float xc = cw0 * x3 + cw1 * x2 + cw2 * x1 + cw3 * x0 + cb;
        x3 = x2; x2 = x1; x1 = x0;
        s_xc[j] = xc;
        __syncthreads();
        float rp = bav, ip = bxv;
#pragma unroll 8
        for (int i = 0; i < HD; ++i) { const float v = s_xc[i]; rp += v * s_wa[i * HD + j]; ip += v * s_wx[i * HD + j]; }
        __syncthreads();
        const float r = sigmoid_f(rp), ig = sigmoid_f(ip);
        const float la = r * lac, a = expf(la), mult = sqrtf(-expm1f(2.f * la));
        h = a * h + mult * (ig * xc);
        bf16_t* g = zr + (size_t)t * DIN + O_GR + ch;
        *g = f2bf(h * bf2f(*g));
    }
}
__global__ void __launch_bounds__(64) k_s5(bf16_t* Z, const float2* lamb, const float* bbr, const float* bbi, const float* c_re, const float* c_im, const float* dd) {
    const int b = blockIdx.x / NG, g = blockIdx.x % NG, p = threadIdx.x;
    float br[GS], bi[GS], cr[GS], ci[GS];
#pragma unroll
    for (int h = 0; h < GS; ++h) { br[h] = bbr[(g * NP + p) * GS + h]; bi[h] = bbi[(g * NP + p) * GS + h]; cr[h] = c_re[(g * GS + h) * NP + p]; ci[h] = c_im[(g * GS + h) * NP + p]; }
    const float2 l = lamb[g * NP + p];
    const float dv = dd[g * GS + (p & 15)];
    float hr = 0.f, hi = 0.f;
    bf16_t* zr = Z + (size_t)b * SEQ * DIN + O_U + g * GS;
    for (int t = 0; t < SEQ; ++t) {
        const float ul = bf2f(zr[(size_t)t * DIN + (p & 15)]);
        float bur = 0.f, bui = 0.f;
#pragma unroll
        for (int h = 0; h < GS; ++h) { const float u = __shfl(ul, h); bur += br[h] * u; bui += bi[h] * u; }
        const float nr = l.x * hr - l.y * hi + bur, ni = l.x * hi + l.y * hr + bui; hr = nr; hi = ni;
        float yv = 0.f;
#pragma unroll
        for (int h = 0; h < GS; ++h) { float v = cr[h] * hr - ci[h] * hi;
#pragma unroll
            for (int o = 1; o < 64; o <<= 1) v += __shfl_xor(v, o);
            yv = (p == h) ? v : yv; }
        if (p < GS) zr[(size_t)t * DIN + p] = f2bf(gelu_tanh(yv + dv * ul));
    }
}
__global__ void __launch_bounds__(256) k_ln(float* X, const float* g, const float* bt, bf16_t* xb) {
    __shared__ float red[8];
    const int row = blockIdx.x, tid = threadIdx.x; float* xr = X + (size_t)row * D;
    float v[8]; float s = 0.f;
#pragma unroll
    for (int i = 0; i < 8; ++i) { v[i] = xr[tid + 256 * i]; s += v[i]; }
#pragma unroll
    for (int o = 1; o < 64; o <<= 1) s += __shfl_xor(s, o);
    if ((tid & 63) == 0) red[tid >> 6] = s;
    __syncthreads();
    const float mean = (red[0] + red[1] + red[2] + red[3]) * (1.f / D);
    float q = 0.f;
#pragma unroll
    for (int i = 0; i < 8; ++i) { v[i] -= mean; q += v[i] * v[i]; }
#pragma unroll
    for (int o = 1; o < 64; o <<= 1) q += __shfl_xor(q, o);
    if ((tid & 63) == 0) red[4 + (tid >> 6)] = q;
    __syncthreads();
    const float rstd = rsqrtf((red[4] + red[5] + red[6] + red[7]) * (1.f / D) + LN_EPS);
#pragma unroll
    for (int i = 0; i < 8; ++i) { const int c = tid + 256 * i; const float y = v[i] * rstd * g[c] + bt[c]; xr[c] = y; if (xb) xb[(size_t)row * D + c] = f2bf(y); }
}
struct EpiZ { bf16_t* Z; __device__ void operator()(int r, int c, float a) const {
    float v = a; if (c >= O_GR && c < O_U) v = gelu_tanh(a); else if (c >= O_GA) v = sigmoid_f(a); Z[(size_t)r * DIN + c] = f2bf(v); } };
struct EpiMix { bf16_t* Z; __device__ void operator()(int r, int c, float a) const {
    bf16_t* p = Z + (size_t)r * DIN + O_GA + c; *p = f2bf(bf2f(*p) * a + bf2f(Z[(size_t)r * DIN + O_GB + c])); } };
struct EpiR1 { const float* x; float* out; __device__ void operator()(int r, int c, float a) const { out[(size_t)r * D + c] = ALPHA * x[(size_t)r * D + c] + a; } };
struct EpiUp { bf16_t* H; const float* b; __device__ void operator()(int r, int c, float a) const { const float v = fmaxf(a + b[c], 0.f); H[(size_t)r * DFF + c] = f2bf(v * v); } };
struct EpiR2 { float* out; const float* b; __device__ void operator()(int r, int c, float a) const { float* p = out + (size_t)r * D + c; *p = ALPHA * (*p) + a + b[c]; } };
}

namespace pg8 {
#define PG8_LAS __attribute__((address_space(3)))
typedef short bf16x8 __attribute__((ext_vector_type(8)));
typedef float f32x4 __attribute__((ext_vector_type(4)));
typedef unsigned u32x4 __attribute__((ext_vector_type(4)));
typedef unsigned u32x2 __attribute__((ext_vector_type(2)));
constexpr int BM = 256, BK = 64, HALF = 128, HTB = HALF * BK * 2  , STAGE_BYTES = 8 * HTB, NXCD = 8, WGM = 8;
__host__ __device__ __forceinline__ int lds_byte(int r, int c) { const int st = (r >> 4) * 2 + (c >> 5), rr = r & 15, cc = c & 31, ob = rr * 64 + cc * 2; return st * 1024 + (ob ^ (((ob >> 9) & 1) << 5)); }
__host__ __device__ __forceinline__ void stage_rc(int b, int& R, int& C) { const int st = b / 1024, sb = b % 1024, swz = sb ^ (((sb >> 9) & 1) << 5); R = (st >> 1) * 16 + swz / 64; C = (st & 1) * 32 + (swz % 64) / 2; }
__host__ __device__ __forceinline__ int perm32(int rho) { const int n = rho >> 4, i = rho & 15; return 8 * (i >> 2) + 4 * n + (i & 3); }
struct Unit { int pm, pn; };
struct Gemm { const bf16_t* A; int lda; const bf16_t* Bt; int ldb; int M, N, K; };
struct StaticOrder {
    int nM, nN, nwg, G, c;
    __host__ __device__ void init(int M_, int N_, int G_, int c_) { nM = M_ / BM; nN = N_ / BM; nwg = nM * nN; G = G_; c = c_; }
    __host__ __device__ bool next(int i, Unit& u) const {
        const long L = (long)i * G + c; if (L >= nwg) return false;
        int wgid = (int)L; { const int q = nwg / NXCD, r = nwg % NXCD, xcd = wgid % NXCD, off = wgid / NXCD; wgid = (xcd < r ? xcd * (q + 1) : r * (q + 1) + (xcd - r) * q) + off; }
        const int nig = WGM * nN, gid = wgid / nig, fm = gid * WGM, gsz = (nM - fm) < WGM ? (nM - fm) : WGM;
        u.pm = fm + ((wgid % nig) % gsz); u.pn = (wgid % nig) / gsz; return true;
    }
    __device__ __forceinline__ void a_ready(const Unit&) const {}
    __device__ __forceinline__ void done(const Unit&) const {}
};
__device__ __forceinline__ unsigned cvt_pk_bf16(float lo, float hi) { unsigned r; asm volatile("v_cvt_pk_bf16_f32 %0, %1, %2" : "=v"(r) : "v"(lo), "v"(hi)); return r; }
__device__ __forceinline__ float bf_lo(unsigned w) { return __uint_as_float(w << 16); }
__device__ __forceinline__ float bf_hi(unsigned w) { return __uint_as_float(w & 0xffff0000u); }
__device__ __forceinline__ float sigm(float x) { return __builtin_amdgcn_rcpf(1.f + __expf(-x)); }
__device__ __forceinline__ float gelu_t(float x) { const float u = 1.5957691216057308f * (x + 0.044715f * x * x * x); return x * sigm(u); }

struct EpiZ {
    static constexpr bool PERM = true, AFTER_DRAIN = false, IDEMP = true;
    bf16_t* Z;
    __device__ __forceinline__ void operator()(const f32x4 (&acc)[2][2][4][2], const Unit& u, int wr, int wc, int fr, int fq) const {
        const int row0 = u.pm * BM + wr * 64 + fr, col0 = u.pn * BM + wc * 32 + 8 * fq;
        const int act = (u.pn >= 20) ? 2 : ((u.pn >= 8 && u.pn < 16) ? 1 : 0);
#pragma unroll
        for (int ai = 0; ai < 2; ++ai)
#pragma unroll
            for (int m = 0; m < 4; ++m) { bf16_t* rowp = Z + (size_t)(row0 + ai * HALF + m * 16) * DIN + col0;
#pragma unroll
                for (int bj = 0; bj < 2; ++bj) { f32x4 v0 = acc[ai][bj][m][0], v1 = acc[ai][bj][m][1];
                    if (act == 1) {
#pragma unroll
                        for (int j = 0; j < 4; ++j) { v0[j] = gelu_t(v0[j]); v1[j] = gelu_t(v1[j]); } }
                    else if (act == 2) {
#pragma unroll
                        for (int j = 0; j < 4; ++j) { v0[j] = sigm(v0[j]); v1[j] = sigm(v1[j]); } }
                    u32x4 w; w.x = cvt_pk_bf16(v0[0], v0[1]); w.y = cvt_pk_bf16(v0[2], v0[3]); w.z = cvt_pk_bf16(v1[0], v1[1]); w.w = cvt_pk_bf16(v1[2], v1[3]);
                    *(u32x4*)(rowp + bj * HALF) = w; } }
    }
};
struct EpiGlu {
    static constexpr bool PERM = true, AFTER_DRAIN = false, IDEMP = false;
    bf16_t* Z;
    __device__ __forceinline__ void operator()(const f32x4 (&acc)[2][2][4][2], const Unit& u, int wr, int wc, int fr, int fq) const {
        const int row0 = u.pm * BM + wr * 64 + fr, col0 = u.pn * HALF + wc * 32 + 8 * fq;
#pragma unroll
        for (int ai = 0; ai < 2; ++ai)
#pragma unroll
            for (int m = 0; m < 4; ++m) { bf16_t* p = Z + (size_t)(row0 + ai * HALF + m * 16) * DIN + O_GB + col0;
                const u32x4 g = *(const u32x4*)p;
                const f32x4 w0 = acc[ai][0][m][0], w1 = acc[ai][0][m][1], v0 = acc[ai][1][m][0], v1 = acc[ai][1][m][1];
                u32x4 o;
                o.x = cvt_pk_bf16(w0[0] * sigm(v0[0]) * bf_lo(g.x), w0[1] * sigm(v0[1]) * bf_hi(g.x));
                o.y = cvt_pk_bf16(w0[2] * sigm(v0[2]) * bf_lo(g.y), w0[3] * sigm(v0[3]) * bf_hi(g.y));
                o.z = cvt_pk_bf16(w1[0] * sigm(v1[0]) * bf_lo(g.z), w1[1] * sigm(v1[1]) * bf_hi(g.z));
                o.w = cvt_pk_bf16(w1[2] * sigm(v1[2]) * bf_lo(g.w), w1[3] * sigm(v1[3]) * bf_hi(g.w));
                *(u32x4*)p = o; }
    }
};
struct EpiMix {
    static constexpr bool PERM = true, AFTER_DRAIN = false, IDEMP = false;
    bf16_t* Z;
    __device__ __forceinline__ void operator()(const f32x4 (&acc)[2][2][4][2], const Unit& u, int wr, int wc, int fr, int fq) const {
        const int row0 = u.pm * BM + wr * 64 + fr, col0 = u.pn * BM + wc * 32 + 8 * fq;
#pragma unroll
        for (int ai = 0; ai < 2; ++ai)
#pragma unroll
            for (int m = 0; m < 4; ++m) { bf16_t* rowp = Z + (size_t)(row0 + ai * HALF + m * 16) * DIN + col0;
#pragma unroll
                for (int bj = 0; bj < 2; ++bj) { bf16_t* pa = rowp + O_GA + bj * HALF; const bf16_t* pb = rowp + O_GB + bj * HALF;
                    const u32x4 ga = *(const u32x4*)pa, yb = *(const u32x4*)pb; const f32x4 a0 = acc[ai][bj][m][0], a1 = acc[ai][bj][m][1];
                    u32x4 o;
                    o.x = cvt_pk_bf16(bf_lo(ga.x) * a0[0] + bf_lo(yb.x), bf_hi(ga.x) * a0[1] + bf_hi(yb.x));
                    o.y = cvt_pk_bf16(bf_lo(ga.y) * a0[2] + bf_lo(yb.y), bf_hi(ga.y) * a0[3] + bf_hi(yb.y));
                    o.z = cvt_pk_bf16(bf_lo(ga.z) * a1[0] + bf_lo(yb.z), bf_hi(ga.z) * a1[1] + bf_hi(yb.z));
                    o.w = cvt_pk_bf16(bf_lo(ga.w) * a1[2] + bf_lo(yb.w), bf_hi(ga.w) * a1[3] + bf_hi(yb.w));
                    *(u32x4*)pa = o; } }
    }
};
struct EpiR1 {
    static constexpr bool PERM = false, AFTER_DRAIN = false, IDEMP = true;
    const float* x; float* out;
    __device__ __forceinline__ void operator()(const f32x4 (&acc)[2][2][4][2], const Unit& u, int wr, int wc, int fr, int fq) const {
        const int row0 = u.pm * BM + wr * 64 + fr, col0 = u.pn * BM + wc * 32 + 4 * fq;
#pragma unroll
        for (int ai = 0; ai < 2; ++ai)
#pragma unroll
            for (int m = 0; m < 4; ++m) { const size_t off = (size_t)(row0 + ai * HALF + m * 16) * D + col0;
#pragma unroll
                for (int bj = 0; bj < 2; ++bj)
#pragma unroll
                    for (int n = 0; n < 2; ++n) { const f32x4 xv = *(const f32x4*)(x + off + bj * HALF + n * 16); *(f32x4*)(out + off + bj * HALF + n * 16) = xv * ALPHA + acc[ai][bj][m][n]; }
                asm volatile("" ::: "memory"); }
    }
};
struct EpiUp {
    static constexpr bool PERM = true, AFTER_DRAIN = false, IDEMP = true;
    bf16_t* H; const float* bias;
    __device__ __forceinline__ void operator()(const f32x4 (&acc)[2][2][4][2], const Unit& u, int wr, int wc, int fr, int fq) const {
        const int row0 = u.pm * BM + wr * 64 + fr, col0 = u.pn * BM + wc * 32 + 8 * fq;
        f32x4 bv[2][2];
#pragma unroll
        for (int bj = 0; bj < 2; ++bj)
#pragma unroll
            for (int n = 0; n < 2; ++n) bv[bj][n] = *(const f32x4*)(bias + col0 + bj * HALF + 4 * n);
#pragma unroll
        for (int ai = 0; ai < 2; ++ai)
#pragma unroll
            for (int m = 0; m < 4; ++m) { bf16_t* rowp = H + (size_t)(row0 + ai * HALF + m * 16) * DFF + col0;
#pragma unroll
                for (int bj = 0; bj < 2; ++bj) { f32x4 v0 = acc[ai][bj][m][0] + bv[bj][0], v1 = acc[ai][bj][m][1] + bv[bj][1];
#pragma unroll
                    for (int j = 0; j < 4; ++j) { v0[j] = fmaxf(v0[j], 0.f); v0[j] *= v0[j]; v1[j] = fmaxf(v1[j], 0.f); v1[j] *= v1[j]; }
                    u32x4 w; w.x = cvt_pk_bf16(v0[0], v0[1]); w.y = cvt_pk_bf16(v0[2], v0[3]); w.z = cvt_pk_bf16(v1[0], v1[1]); w.w = cvt_pk_bf16(v1[2], v1[3]);
                    *(u32x4*)(rowp + bj * HALF) = w; } }
    }
};
struct EpiR2 {
    static constexpr bool PERM = false, AFTER_DRAIN = false, IDEMP = false;
    float* out; const float* bias;
    __device__ __forceinline__ void operator()(const f32x4 (&acc)[2][2][4][2], const Unit& u, int wr, int wc, int fr, int fq) const {
        const int row0 = u.pm * BM + wr * 64 + fr, col0 = u.pn * BM + wc * 32 + 4 * fq;
        f32x4 bv[2][2];
#pragma unroll
        for (int bj = 0; bj < 2; ++bj)
#pragma unroll
            for (int n = 0; n < 2; ++n) bv[bj][n] = *(const f32x4*)(bias + col0 + bj * HALF + n * 16);
#pragma unroll
        for (int ai = 0; ai < 2; ++ai)
#pragma unroll
            for (int m = 0; m < 4; ++m) { const size_t off = (size_t)(row0 + ai * HALF + m * 16) * D + col0;
#pragma unroll
                for (int bj = 0; bj < 2; ++bj)
#pragma unroll
                    for (int n = 0; n < 2; ++n) { float* p = out + off + bj * HALF + n * 16; const f32x4 xv = *(const f32x4*)p; *(f32x4*)p = xv * ALPHA + acc[ai][bj][m][n] + bv[bj][n]; }
                asm volatile("" ::: "memory"); }
    }
};

template <class Epi, class Sched, bool ALIGN_EPI = true>
__device__ __forceinline__ void gemm_phase(PG8_LAS unsigned char* lds, const Gemm g, const Sched& S, const Epi& E) {
    const int tid = threadIdx.x, wid = __builtin_amdgcn_readfirstlane(tid >> 6), lane = tid & 63, wr = wid >> 2, wc = wid & 3, fr = lane & 15, fq = lane >> 4;
    const int K = g.K, nt = K / BK;
    unsigned voffA[2], voffB[2];
#pragma unroll
    for (int i = 0; i < 2; ++i) { int R, C; stage_rc(tid * 16 + i * 8192, R, C); const int Rb = Epi::PERM ? ((R & ~31) + perm32(R & 31)) : R;
        voffA[i] = (unsigned)(R * g.lda + C) * 2u; voffB[i] = (unsigned)(Rb * g.ldb + C) * 2u; }
    const size_t kstep = (size_t)(BK * 2);
    const size_t hstepA = (size_t)HALF * g.lda * 2, hstepB = (size_t)HALF * g.ldb * 2;
    const size_t tstepA = 2 * hstepA, tstepB = 2 * hstepB;
    const unsigned ldsw = (unsigned)wid * 1024u;
    const int aoff = lds_byte(wr * 64 + fr, fq * 8), boff = lds_byte(wc * 32 + fr, fq * 8);
#define PG8_SA(b, h) (((b) * 2 + (h)) * HTB)
#define PG8_SB(b, h) ((4 + (b) * 2 + (h)) * HTB)
#define PG8_STAGE(bufoff, gbase, voff) do { _Pragma("unroll") for (int _i = 0; _i < 2; ++_i) \
        __builtin_amdgcn_global_load_lds((const unsigned*)((const char*)(gbase) + (voff)[_i]), (PG8_LAS unsigned*)(lds + (bufoff) + ldsw + _i * 8192), 16, 0, 0); } while (0)
#define PG8_LDA(dst, b, h) do { _Pragma("unroll") for (int m = 0; m < 4; ++m) _Pragma("unroll") for (int k = 0; k < 2; ++k) dst[m][k] = *(const PG8_LAS bf16x8*)(lds + PG8_SA(b, h) + aoff + m * 2048 + k * 1024); } while (0)
#define PG8_LDB(dst, b, h) do { _Pragma("unroll") for (int n = 0; n < 2; ++n) _Pragma("unroll") for (int k = 0; k < 2; ++k) dst[n][k] = *(const PG8_LAS bf16x8*)(lds + PG8_SB(b, h) + boff + n * 2048 + k * 1024); } while (0)
#define PG8_MMA(ai, bj, At, Bt) do { __builtin_amdgcn_s_setprio(1); _Pragma("unroll") for (int m = 0; m < 4; ++m) _Pragma("unroll") for (int n = 0; n < 2; ++n) _Pragma("unroll") for (int k = 0; k < 2; ++k) \
        acc[ai][bj][m][n] = __builtin_amdgcn_mfma_f32_16x16x32_bf16(Bt[n][k], At[m][k], acc[ai][bj][m][n], 0, 0, 0); __builtin_amdgcn_s_setprio(0); } while (0)
#define PG8_WAIT_V(n) asm volatile("s_waitcnt vmcnt(" #n ")" ::: "memory")
#define PG8_WAIT_L(n) asm volatile("s_waitcnt lgkmcnt(" #n ")" ::: "memory")
#define PG8_BAR __builtin_amdgcn_s_barrier()
#define PG8_SCHED __builtin_amdgcn_sched_barrier(0)
    Unit cur, nxt; int ui = 0;
    if (!S.next(0, cur)) return;
    f32x4 acc[2][2][4][2];
#pragma unroll
    for (int a = 0; a < 2; ++a)
#pragma unroll
        for (int b = 0; b < 2; ++b)
#pragma unroll
            for (int m = 0; m < 4; ++m)
#pragma unroll
                for (int n = 0; n < 2; ++n) acc[a][b][m][n] = (f32x4){0.f, 0.f, 0.f, 0.f};
    bf16x8 At[4][2], B0[2][2], B1[2][2];
    const char* cA = (const char*)g.A + (size_t)cur.pm * tstepA; const char* cB = (const char*)g.Bt + (size_t)cur.pn * tstepB;
    S.a_ready(cur);
    PG8_STAGE(PG8_SB(0, 0), cB, voffB); PG8_STAGE(PG8_SB(0, 1), cB + hstepB, voffB); PG8_STAGE(PG8_SA(0, 0), cA, voffA); PG8_STAGE(PG8_SA(0, 1), cA + hstepA, voffA);
    if (wr == 1) PG8_BAR;
    PG8_WAIT_V(2); PG8_BAR;
    PG8_STAGE(PG8_SB(1, 0), cB + kstep, voffB); PG8_STAGE(PG8_SA(1, 0), cA + kstep, voffA); PG8_STAGE(PG8_SB(1, 1), cB + hstepB + kstep, voffB);
    PG8_WAIT_V(6); PG8_BAR;
    for (;;) {
        const bool has_next = S.next(ui + 1, nxt);
        const char* nA = has_next ? (const char*)g.A + (size_t)nxt.pm * tstepA : cA; const char* nB = has_next ? (const char*)g.Bt + (size_t)nxt.pn * tstepB : cB;
        for (int t = 0; t < nt; t += 2) {
            const bool last = (t == nt - 2);
            const char* a1 = cA + (size_t)(t + 1) * kstep;
            const char* a2 = last ? nA : cA + (size_t)(t + 2) * kstep; const char* b2 = last ? nB : cB + (size_t)(t + 2) * kstep;
            const char* a3 = a2 + kstep; const char* b3 = b2 + kstep;
            if (last && has_next) S.a_ready(nxt);
            PG8_LDB(B0, 0, 0); PG8_LDB(B1, 0, 1); PG8_SCHED; PG8_LDA(At, 0, 0); PG8_STAGE(PG8_SA(1, 1), a1 + hstepA, voffA);
            PG8_WAIT_V(8); PG8_WAIT_L(0); PG8_BAR; PG8_MMA(0, 0, At, B0); PG8_MMA(0, 1, At, B1); PG8_BAR; PG8_SCHED;
            PG8_LDA(At, 0, 1); PG8_STAGE(PG8_SB(0, 0), b2, voffB); PG8_STAGE(PG8_SB(0, 1), b2 + hstepB, voffB); PG8_STAGE(PG8_SA(0, 0), a2, voffA);
            PG8_WAIT_V(8); PG8_WAIT_L(0); PG8_BAR; PG8_MMA(1, 0, At, B0); PG8_MMA(1, 1, At, B1); PG8_BAR; PG8_SCHED;
            PG8_LDB(B0, 1, 0); PG8_LDB(B1, 1, 1); PG8_SCHED; PG8_LDA(At, 1, 0); PG8_STAGE(PG8_SA(0, 1), a2 + hstepA, voffA);
            PG8_WAIT_V(8); PG8_WAIT_L(0); PG8_BAR; PG8_MMA(0, 0, At, B0); PG8_MMA(0, 1, At, B1); PG8_BAR; PG8_SCHED;
            PG8_LDA(At, 1, 1); PG8_STAGE(PG8_SB(1, 0), b3, voffB); PG8_STAGE(PG8_SB(1, 1), b3 + hstepB, voffB); PG8_STAGE(PG8_SA(1, 0), a3, voffA);
            PG8_WAIT_V(8); PG8_WAIT_L(0); PG8_BAR; PG8_MMA(1, 0, At, B0); PG8_MMA(1, 1, At, B1); PG8_BAR; PG8_SCHED;
        }
        if constexpr (ALIGN_EPI) { if (wr == 0) PG8_BAR; }
        E(acc, cur, wr, wc, fr, fq); S.done(cur);
#if defined(MK_EPI2)
        if constexpr (Epi::IDEMP) { asm volatile("" ::: "memory"); E(acc, cur, wr, wc, fr, fq); }
#endif
        if (!has_next) break;
#pragma unroll
        for (int a = 0; a < 2; ++a)
#pragma unroll
            for (int b = 0; b < 2; ++b)
#pragma unroll
                for (int m = 0; m < 4; ++m)
#pragma unroll
                    for (int n = 0; n < 2; ++n) acc[a][b][m][n] = (f32x4){0.f, 0.f, 0.f, 0.f};
        cur = nxt; cA = nA; cB = nB; ++ui;
        if constexpr (ALIGN_EPI) { if (wr == 1) PG8_BAR; }
    }
    PG8_WAIT_V(0);
    if constexpr (!ALIGN_EPI) { if (wr == 0) PG8_BAR; }
    PG8_BAR;
#undef PG8_SA
#undef PG8_SB
#undef PG8_STAGE
#undef PG8_LDA
#undef PG8_LDB
#undef PG8_MMA
#undef PG8_WAIT_V
#undef PG8_WAIT_L
#undef PG8_BAR
#undef PG8_SCHED
}
}

namespace scan {
#define SLAS __attribute__((address_space(3)))
typedef short bf16x8 __attribute__((ext_vector_type(8)));
typedef float f32x16 __attribute__((ext_vector_type(16)));
typedef float f32x4 __attribute__((ext_vector_type(4)));
typedef unsigned u32x4 __attribute__((ext_vector_type(4)));
typedef unsigned u32x2 __attribute__((ext_vector_type(2)));
typedef __bf16 bf16x2v __attribute__((ext_vector_type(2)));
typedef float f32x2v __attribute__((ext_vector_type(2)));
#define MFMA32(a, b, c) __builtin_amdgcn_mfma_f32_32x32x16_bf16((a), (b), (c), 0, 0, 0)
__device__ __forceinline__ unsigned pk2c(float a, float b) { f32x2v f = {a, b}; bf16x2v r = __builtin_convertvector(f, bf16x2v); return __builtin_bit_cast(unsigned, r); }
__device__ __forceinline__ bf16x8 pack8(float a0, float a1, float a2, float a3, float a4, float a5, float a6, float a7) {
    u32x4 p; p.x = pk2c(a0, a1); p.y = pk2c(a2, a3); p.z = pk2c(a4, a5); p.w = pk2c(a6, a7); return __builtin_bit_cast(bf16x8, p); }
__device__ __forceinline__ int crow(int i, int hf) { return (i & 3) + 8 * (i >> 2) + 4 * hf; }
__device__ __forceinline__ float sigm(float x) { return __builtin_amdgcn_rcpf(1.f + __expf(-x)); }
__device__ __forceinline__ float gelu_t(float x) { const float u = 1.5957691216057308f * (x + 0.044715f * x * x * x); return x * sigm(u); }

constexpr int RG_NC = 32, RG_L = SEQ / RG_NC, RG_STEPS = RG_L / 16, RG_NS = NB * RG_NC;
constexpr int S5_NC = 256, S5_L = SEQ / S5_NC, S5_NS = NB * S5_NC, S5_UNITS = (S5_NS / 32) * NG;
constexpr size_t WS_RGP = WS_X1B, WS_RGS = WS_RGP + 512 * 1024, WS_RGH = WS_RGS + 512 * 1024;
constexpr size_t WS_S5S = WS_X1B + 2 * MiB, WS_S5H = WS_S5S + 16 * MiB;
static_assert(WS_S5H + 16 * MiB <= WS_Z, "scan scratch fits the X1B region");
constexpr int RG_HB_LDS = 51200;

__device__ __forceinline__ void rglru_pack_weights(const float* __restrict__ wa, const float* __restrict__ wx, bf16_t* RGW, int idx) {
    const int lane = idx & 63, ks = (idx >> 6) & 7, gate = (idx >> 9) & 1, w4 = (idx >> 10) & 3, hd = idx >> 12;
    const float* p = (gate ? wx : wa) + (size_t)hd * HD * HD + (size_t)(16 * ks + 8 * (lane >> 5)) * HD + w4 * 32 + (lane & 31);
    ((bf16x8*)RGW)[idx] = pack8(p[0], p[HD], p[2 * HD], p[3 * HD], p[4 * HD], p[5 * HD], p[6 * HD], p[7 * HD]);
}
template <bool PASS_B>
__device__ __forceinline__ void rglru_pass(SLAS unsigned char* lds, bf16_t* Z, const float* __restrict__ conv_w, const float* __restrict__ conv_b, const bf16_t* __restrict__ RGW, const float* __restrict__ ba,
                                           const float* __restrict__ bxp, const float* __restrict__ lam, float* RGP, float* RGS, const float* RGH, int bx, int G) {
    const int tid = threadIdx.x, lane = tid & 63, wave = __builtin_amdgcn_readfirstlane(tid >> 6), hb = wave >> 2, w4 = wave & 3, t4 = tid & 255;
    const int col = lane & 31, hf = lane >> 5;
    SLAS unsigned char* base = lds + hb * RG_HB_LDS;
    for (int ub = bx; ub < 256; ub += G) {
        const int unit = 2 * ub + hb, hd = unit & 15, sp = unit >> 4;
        const int cs = t4 >> 7, cch = t4 & 127, s_conv = 2 * sp + cs, chc = hd * HD + cch;
        const int cconv = s_conv % RG_NC;
        const bf16_t* zx = Z + (size_t)((s_conv / RG_NC) * SEQ + cconv * RG_L) * DIN + O_XR + chc;
        const float cw0 = conv_w[0 * D + chc], cw1 = conv_w[1 * D + chc], cw2 = conv_w[2 * D + chc], cw3 = conv_w[3 * D + chc], cb = conv_b[chc];
        float x1 = 0.f, x2 = 0.f, x3 = 0.f;
        if (cconv > 0) { x1 = bf2f(zx[-(ptrdiff_t)DIN]); x2 = bf2f(zx[-2 * (ptrdiff_t)DIN]); x3 = bf2f(zx[-3 * (ptrdiff_t)DIN]); }
        const int s_scan = 2 * sp + hf, ch = hd * HD + w4 * 32 + col;
        bf16_t* zg = Z + (size_t)((s_scan / RG_NC) * SEQ + (s_scan % RG_NC) * RG_L) * DIN + O_GR + ch;
        const float bav = ba[ch], bxv = bxp[ch], lac = -8.f * log1pf(expf(-lam[ch]));
        bf16x8 Br[8], Bi[8];
        {
            const bf16x8* wf = (const bf16x8*)RGW + (size_t)((hd * 4 + w4) * 2) * 8 * 64 + lane;
#pragma unroll
            for (int ks = 0; ks < 8; ++ks) { Br[ks] = wf[ks * 64]; Bi[ks] = wf[(8 + ks) * 64]; }
        }
        float h = PASS_B ? RGH[(size_t)s_scan * D + ch] : 0.f, P = 1.f;
        bf16_t cur[16];
#pragma unroll
        for (int k = 0; k < 16; ++k) cur[k] = zx[(size_t)k * DIN];
        for (int step = 0; step < RG_STEPS; ++step) {
            const int pb = step & 1;
            SLAS bf16_t* At = (SLAS bf16_t*)(base + pb * 8704); SLAS float* Ft = (SLAS float*)(base + 17408 + pb * 16896);
            bf16_t gg[16];
            if (PASS_B) {
#pragma unroll
                for (int i = 0; i < 16; ++i) gg[i] = zg[(size_t)(16 * step + i) * DIN];
            }
#pragma unroll
            for (int k = 0; k < 16; ++k) {
                const float x0 = bf2f(cur[k]);
                const float xc = cw0 * x3 + cw1 * x2 + cw2 * x1 + cw3 * x0 + cb;
                x3 = x2; x2 = x1; x1 = x0;
                const int row = (k & 3) + 8 * (k >> 2) + 4 * cs;
                At[row * 136 + cch] = (bf16_t)(pk2c(xc, 0.f) & 0xffffu); Ft[row * 132 + cch] = xc;
            }
            if (step + 1 < RG_STEPS) {
#pragma unroll
                for (int k = 0; k < 16; ++k) cur[k] = zx[(size_t)(16 * (step + 1) + k) * DIN];
            }
            __syncthreads();
            f32x16 accR, accI;
#pragma unroll
            for (int i = 0; i < 16; ++i) { accR[i] = 0.f; accI[i] = 0.f; }
#pragma unroll
            for (int ks = 0; ks < 8; ++ks) { const bf16x8 af = *(const SLAS bf16x8*)(At + col * 136 + 16 * ks + 8 * hf);
                accR = MFMA32(af, Br[ks], accR); accI = MFMA32(af, Bi[ks], accI); }
#pragma unroll
            for (int i = 0; i < 16; ++i) {
                const float xc = Ft[crow(i, hf) * 132 + w4 * 32 + col];
                const float r = sigm(accR[i] + bav), ig = sigm(accI[i] + bxv);
                const float la = r * lac, av = __expf(la), x = 2.f * la;
                const float m2 = -x * (1.f + x * (0.5f + x * (0.16666667f + x * (0.041666668f + x * (0.008333334f + x * 0.0013888889f)))));
                const float bb = __builtin_amdgcn_sqrtf(m2) * (ig * xc);
                h = av * h + bb;
                if (PASS_B) zg[(size_t)(16 * step + i) * DIN] = (bf16_t)(pk2c(h * bf2f(gg[i]), 0.f) & 0xffffu);
                else P *= av;
                if ((i & 3) == 3) __builtin_amdgcn_sched_barrier(0);
            }
        }
        if (!PASS_B) { RGP[(size_t)s_scan * D + ch] = P; RGS[(size_t)s_scan * D + ch] = h; }
        __syncthreads();
    }
}
__device__ __forceinline__ void rglru_carry(const float* RGP, const float* RGS, float* RGH, int idx) {
    const int b = idx / D, ch = idx % D; float H = 0.f;
#pragma unroll 8
    for (int c = 0; c < RG_NC; ++c) { const size_t o = (size_t)(b * RG_NC + c) * D + ch; RGH[o] = H; H = RGP[o] * H + RGS[o]; }
}

__device__ __forceinline__ size_t s5_idx(int g, int T, int row, int s) { return ((size_t)(g * 128 + (T >> 1) * 64 + (T & 1) * 32 + row)) * S5_NS + s; }
template <bool PASS_B>
__device__ __forceinline__ void s5_pass(bf16_t* Z, const float2* __restrict__ lamtab, const float* __restrict__ bbr, const float* __restrict__ bbi, const float* __restrict__ c_re, const float* __restrict__ c_im,
                                        const float* __restrict__ dd, float* S5S, const float* S5H, SLAS f32x2v* ltab  , int gw, int NGW, int lane) {
    const int col = lane & 31, hf = lane >> 5;
    for (int unit = gw; unit < S5_UNITS; unit += NGW) {
        const int g = unit & (NG - 1), sset = unit / NG;
        const int s = sset * 32 + col, b = s / S5_NC, c = s % S5_NC;
        bf16_t* zu = Z + ((size_t)b * SEQ + (size_t)c * S5_L) * DIN + O_U + g * GS;
        bf16x8 Ab[4];
#pragma unroll
        for (int T = 0; T < 4; ++T) { const float* src = ((T >> 1) ? bbi : bbr) + (size_t)(g * NP + 32 * (T & 1) + col) * GS + 8 * hf;
            Ab[T] = pack8(src[0], src[1], src[2], src[3], src[4], src[5], src[6], src[7]); }
        { const int e_hf = lane >> 5, e_tp = (lane >> 4) & 1, e_i = lane & 15; const float2 lv = lamtab[g * NP + 32 * e_tp + crow(e_i, e_hf)]; f32x2v lw = {lv.x, lv.y}; ltab[lane] = lw; }
        f32x16 h[4];
#pragma unroll
        for (int T = 0; T < 4; ++T)
#pragma unroll
            for (int i = 0; i < 16; ++i) h[T][i] = PASS_B ? S5H[s5_idx(g, T, crow(i, hf), s)] : 0.f;
        bf16x8 Ac[4][2], Adh, Adl;
        if (PASS_B) {
            const int hp = col & 15; const bool live = col < 16;
#pragma unroll
            for (int T = 0; T < 4; ++T)
#pragma unroll
                for (int sk = 0; sk < 2; ++sk) { float v[8];
#pragma unroll
                    for (int j = 0; j < 8; ++j) { const int p = 32 * (T & 1) + 16 * sk + 8 * (j >> 2) + 4 * hf + (j & 3);
                        const float cv = (T < 2) ? c_re[(size_t)(g * GS + hp) * NP + p] : -c_im[(size_t)(g * GS + hp) * NP + p]; v[j] = live ? cv : 0.f; }
                    Ac[T][sk] = pack8(v[0], v[1], v[2], v[3], v[4], v[5], v[6], v[7]); }
            const float dv = dd[g * GS + hp]; const float dhi = __uint_as_float(pk2c(dv, 0.f) << 16), dlo = dv - dhi;
            float vh[8], vl[8];
#pragma unroll
            for (int j = 0; j < 8; ++j) { const bool on = live && (hp == 8 * hf + j); vh[j] = on ? dhi : 0.f; vl[j] = on ? dlo : 0.f; }
            Adh = pack8(vh[0], vh[1], vh[2], vh[3], vh[4], vh[5], vh[6], vh[7]); Adl = pack8(vl[0], vl[1], vl[2], vl[3], vl[4], vl[5], vl[6], vl[7]);
        }
        bf16x8 u = *(const bf16x8*)(zu + 8 * hf);
        for (int step = 0; step < S5_L; ++step) {
            bf16x8 un = u;
            if (step + 1 < S5_L) un = *(const bf16x8*)(zu + (size_t)(step + 1) * DIN + 8 * hf);
            asm volatile("" ::: "memory");
#pragma unroll
            for (int tp = 0; tp < 2; ++tp) { f32x16 tr, ti;
#pragma unroll
                for (int i = 0; i < 16; i += 2) { const f32x4 l2 = *(const SLAS f32x4*)(ltab + (hf * 2 + tp) * 16 + i);
                    tr[i] = l2[0] * h[tp][i] - l2[1] * h[tp + 2][i]; ti[i] = l2[0] * h[tp + 2][i] + l2[1] * h[tp][i];
                    tr[i + 1] = l2[2] * h[tp][i + 1] - l2[3] * h[tp + 2][i + 1]; ti[i + 1] = l2[2] * h[tp + 2][i + 1] + l2[3] * h[tp][i + 1]; }
                h[tp] = MFMA32(Ab[tp], u, tr); h[tp + 2] = MFMA32(Ab[tp + 2], u, ti);
                __builtin_amdgcn_sched_barrier(0); }
            if (PASS_B) {
                f32x16 y;
#pragma unroll
                for (int i = 0; i < 16; ++i) y[i] = 0.f;
                y = MFMA32(Adh, u, y); y = MFMA32(Adl, u, y);
#pragma unroll
                for (int T = 0; T < 4; ++T)
#pragma unroll
                    for (int sk = 0; sk < 2; ++sk) { const bf16x8 xb = pack8(h[T][8 * sk], h[T][8 * sk + 1], h[T][8 * sk + 2], h[T][8 * sk + 3], h[T][8 * sk + 4], h[T][8 * sk + 5], h[T][8 * sk + 6], h[T][8 * sk + 7]);
                        y = MFMA32(Ac[T][sk], xb, y); }
                u32x2 o0, o1; o0.x = pk2c(gelu_t(y[0]), gelu_t(y[1])); o0.y = pk2c(gelu_t(y[2]), gelu_t(y[3])); o1.x = pk2c(gelu_t(y[4]), gelu_t(y[5])); o1.y = pk2c(gelu_t(y[6]), gelu_t(y[7]));
                bf16_t* zo = zu + (size_t)step * DIN + 4 * hf;
                *(u32x2*)zo = o0; *(u32x2*)(zo + 8) = o1;
            }
            u = un;
        }
        if (!PASS_B) {
#pragma unroll
            for (int T = 0; T < 4; ++T)
#pragma unroll
                for (int i = 0; i < 16; ++i) S5S[s5_idx(g, T, crow(i, hf), s)] = h[T][i];
        }
    }
}
__device__ __forceinline__ void s5_carry(const float2* __restrict__ lamtab, const float* S5S, float* S5H, int idx) {
    const int b = idx / (NG * NP), gp = idx % (NG * NP), g = gp / NP, p = gp % NP;
    float2 L = lamtab[gp];
#pragma unroll
    for (int k = 0; k < 5; ++k) { const float nr = L.x * L.x - L.y * L.y, ni = 2.f * L.x * L.y; L.x = nr; L.y = ni; }
    static_assert(S5_L == 32, "lambda^L by 5 squarings");
    const size_t ore = ((size_t)(g * 128 + p)) * S5_NS + (size_t)b * S5_NC, oim = ore + (size_t)64 * S5_NS;
    const f32x4* sre = (const f32x4*)(S5S + ore); const f32x4* sim = (const f32x4*)(S5S + oim);
    f32x4* hre = (f32x4*)(S5H + ore); f32x4* him = (f32x4*)(S5H + oim);
    float Hr = 0.f, Hi = 0.f;
#pragma unroll 4
    for (int c4 = 0; c4 < S5_NC / 4; ++c4) {
        const f32x4 vr = sre[c4], vi = sim[c4]; f32x4 orr, oi;
#pragma unroll
        for (int j = 0; j < 4; ++j) { orr[j] = Hr; oi[j] = Hi; const float nr = L.x * Hr - L.y * Hi + vr[j], ni = L.x * Hi + L.y * Hr + vi[j]; Hr = nr; Hi = ni; }
        hre[c4] = orr; him[c4] = oi;
    }
}
}

namespace cg = cooperative_groups;
#define LAS __attribute__((address_space(3)))
constexpr int NWAVES = 8, NTHREADS = NWAVES * 64;
constexpr int LDS_BYTES = 147456;
typedef float f32x4 __attribute__((ext_vector_type(4)));
typedef unsigned u32x4 __attribute__((ext_vector_type(4)));
typedef unsigned u32x2 __attribute__((ext_vector_type(2)));
struct Args { const float* in[N_IN]; float* out; unsigned char* ws; int ph_lo, ph_hi; };
static_assert(sizeof(Args) == (N_IN + 2) * 8 + 8, "Args has no padding");

__device__ __forceinline__ unsigned pk2(float lo, float hi) { return pg8::cvt_pk_bf16(lo, hi); }
__device__ __forceinline__ int rowmap(int mode, int n) { return mode == 0 ? n : ((n >> 7) * 256 + (mode == 2 ? 128 : 0) + (n & 127)); }
__device__ __forceinline__ void p0_transpose_item(const float* __restrict__ W, int K, int N, bf16_t* __restrict__ WT, int mode, LAS float* scr, int item, int lane) {
    const int nblk = N / 32, kb = item / nblk, nb = item % nblk, k0 = 64 * kb, n0 = 32 * nb;
#pragma unroll 8
    for (int i = 0; i < 32; ++i) { const int kk = 2 * i + (lane >> 5); scr[kk * 33 + (lane & 31)] = W[(size_t)(k0 + kk) * N + n0 + (lane & 31)]; }
    asm volatile("s_waitcnt lgkmcnt(0)" ::: "memory");
    const int c = lane & 7, rbase = rowmap(mode, n0);
#pragma unroll
    for (int j = 0; j < 4; ++j) { const int n = (lane >> 3) + 8 * j; const LAS float* s = scr + (8 * c) * 33 + n;
        u32x4 o; o.x = pk2(s[0 * 33], s[1 * 33]); o.y = pk2(s[2 * 33], s[3 * 33]); o.z = pk2(s[4 * 33], s[5 * 33]); o.w = pk2(s[6 * 33], s[7 * 33]);
        *(u32x4*)(WT + (size_t)(rbase + n) * K + k0 + 8 * c) = o; }
    asm volatile("s_waitcnt lgkmcnt(0)" ::: "memory");
}
__device__ __forceinline__ float wave_sum(float v) {
#pragma unroll
    for (int o = 1; o < 64; o <<= 1) v += __shfl_xor(v, o);
    return v;
}
__device__ __forceinline__ void ln_row(float* xrow, const float* __restrict__ g, const float* __restrict__ bt, bf16_t* orow, int lane) {
    f32x4* xr = (f32x4*)xrow + lane;
    f32x4 v[8]; float s = 0.f;
#pragma unroll
    for (int j = 0; j < 8; ++j) { v[j] = xr[64 * j]; s += (v[j].x + v[j].y) + (v[j].z + v[j].w); }
    const float mean = wave_sum(s) * (1.f / D); float s2 = 0.f;
#pragma unroll
    for (int j = 0; j < 8; ++j) { v[j] = v[j] - mean; s2 += (v[j].x * v[j].x + v[j].y * v[j].y) + (v[j].z * v[j].z + v[j].w * v[j].w); }
    const float rstd = rsqrtf(wave_sum(s2) * (1.f / D) + LN_EPS);
#pragma unroll
    for (int j = 0; j < 8; ++j) { const f32x4 gv = *((const f32x4*)g + lane + 64 * j), bv = *((const f32x4*)bt + lane + 64 * j);
        const f32x4 y = v[j] * rstd * gv + bv; xr[64 * j] = y;
        if (orow) { u32x2 w; w.x = pk2(y.x, y.y); w.y = pk2(y.z, y.w); *((u32x2*)orow + lane + 64 * j) = w; } }
}


#define XB_TMO      128
#define XB_XCNT(j)  (256  + 64 * (j))
#define XB_XSUB(j)  (1280 + 64 * (j))
#define XB_XGEN(j)  (2304 + 64 * (j))
#define XB_TOP      3328
#define XB_TOPGEN   3392
#define XCD_BAR_WORDS 3456
#define XB_SPIN_CAP (1u << 18)
__device__ __forceinline__ unsigned xb_ld(unsigned* p)              { return __hip_atomic_load(p, __ATOMIC_RELAXED, __HIP_MEMORY_SCOPE_AGENT); }
__device__ __forceinline__ unsigned xb_add(unsigned* p, unsigned v) { return __hip_atomic_fetch_add(p, v, __ATOMIC_RELAXED, __HIP_MEMORY_SCOPE_AGENT); }
__device__ __forceinline__ unsigned xb_xcc_id() { return (unsigned)__builtin_amdgcn_s_getreg((3 << 11) | 20) & 0xFu; }
#define XB_SPIN(cond, bar) do { unsigned _sp = 0; while (cond) { __builtin_amdgcn_s_sleep(1); \
    if ((++_sp & 255u) == 0u) { if (xb_ld(&(bar)[XB_TMO])) break; if (_sp > XB_SPIN_CAP) { atomicAdd(&(bar)[XB_TMO], 1u); break; } } } } while (0)
struct XcdBarrier { unsigned* bar; unsigned x; volatile LAS unsigned* st; };
__device__ __forceinline__ XcdBarrier xcd_barrier_post(unsigned* bar, volatile LAS unsigned* st) {
    XcdBarrier b; b.bar = bar; b.x = xb_xcc_id(); b.st = st;
    if (threadIdx.x == 0) (void)xb_add(&bar[XB_XCNT(b.x)], 1u);
    return b;
}
__device__ __forceinline__ void xcd_barrier_complete(unsigned* bar, unsigned x, unsigned& nloc, unsigned& nx) {
    const unsigned G = gridDim.x * gridDim.y * gridDim.z;
    unsigned sum, cnt, mine, sp = 0u;
    for (;;) {
        sum = 0u; cnt = 0u; mine = 0u;
#pragma unroll
        for (unsigned j = 0; j < 16; ++j) { const unsigned c = xb_ld(&bar[XB_XCNT(j)]); sum += c; cnt += (c > 0u) ? 1u : 0u; mine = (j == x) ? c : mine; }
        if (sum == G) break;
        __builtin_amdgcn_s_sleep(1);
        if ((++sp & 255u) == 0u) { if (xb_ld(&bar[XB_TMO])) break; if (sp > XB_SPIN_CAP) { atomicAdd(&bar[XB_TMO], 1u); break; } }
    }
    nloc = mine > 0u ? mine : 1u; nx = cnt > 0u ? cnt : 1u;
}
__device__ __forceinline__ void xcd_barrier(const XcdBarrier& b) {
    asm volatile("s_waitcnt vmcnt(0)" ::: "memory");
    __syncthreads();
    if (threadIdx.x == 0) {
        unsigned* bar = b.bar;
        __builtin_amdgcn_s_waitcnt(0);
        unsigned nloc = b.st[0], nx = b.st[1];
        if (nloc == 0u) { xcd_barrier_complete(bar, b.x, nloc, nx); b.st[0] = nloc; b.st[1] = nx; }
        const unsigned old = xb_add(&bar[XB_XSUB(b.x)], 1u);
        const unsigned gen = old / nloc;
        if (old + 1u == (gen + 1u) * nloc) {
            __builtin_amdgcn_fence(__ATOMIC_RELEASE, "agent");
            asm volatile("s_waitcnt vmcnt(0)" ::: "memory");
            const unsigned og = xb_add(&bar[XB_TOP], 1u);
            const unsigned tg = og / nx;
            if (og + 1u == (tg + 1u) * nx) xb_add(&bar[XB_TOPGEN], 1u);
            else XB_SPIN(xb_ld(&bar[XB_TOPGEN]) == tg, bar);
            __builtin_amdgcn_fence(__ATOMIC_ACQUIRE, "agent");
            xb_add(&bar[XB_XGEN(b.x)], 1u);
            asm volatile("s_waitcnt vmcnt(0)" ::: "memory");
        } else {
            XB_SPIN(xb_ld(&bar[XB_XGEN(b.x)]) == gen, bar);
            __builtin_amdgcn_fence(__ATOMIC_ACQUIRE, "agent");
            asm volatile("s_waitcnt vmcnt(0)" ::: "memory");
        }
    }
    __syncthreads();
}

__global__ void __launch_bounds__(NTHREADS, 2) mk_fwd(Args a) {
    extern __shared__ __attribute__((aligned(16))) unsigned char lds_raw[];
    LAS unsigned char* lds = (LAS unsigned char*)lds_raw;
    cg::grid_group grid = cg::this_grid();
    const int tid = threadIdx.x, lane = tid & 63, wave = __builtin_amdgcn_readfirstlane(tid >> 6);
    const int G = gridDim.x, bx = blockIdx.x;
    const int gw = bx * NWAVES + wave, NGW = G * NWAVES;
    unsigned char* ws = a.ws;
    bf16_t *Wt_in = (bf16_t*)(ws + WS_WIN), *Wt_a = (bf16_t*)(ws + WS_WA), *Wt_glu = (bf16_t*)(ws + WS_WGLU), *Wt_out = (bf16_t*)(ws + WS_WOUT), *Wt_up = (bf16_t*)(ws + WS_WUP), *Wt_down = (bf16_t*)(ws + WS_WDOWN);
    bf16_t *X1B = (bf16_t*)(ws + WS_X1B), *Z = (bf16_t*)(ws + WS_Z), *HMID = (bf16_t*)(ws + WS_Z), *XB = (bf16_t*)a.out;
    const int lo = a.ph_lo, hi = a.ph_hi;
#ifndef MK_DUP
#define MK_DUP 0
#endif
#define DUP(k) (((MK_DUP >> (k)) & 1) != 0)
#define IN(k) (lo <= (k) && (k) < hi)
    volatile LAS unsigned* MISC = (volatile LAS unsigned*)(lds + LDS_BYTES - 64);
    if (tid < 16) MISC[tid] = 0u;
    __syncthreads();
    XcdBarrier xbar = xcd_barrier_post((unsigned*)(ws + WS_CTL), MISC);
#ifndef MK_CG_SEAMS
#define MK_CG_SEAMS 0
#endif
#define SEAM(k) do { if (IN(k) && IN((k) + 1)) { if ((k) < MK_CG_SEAMS) grid.sync(); else xcd_barrier(xbar); } } while (0)

    if (IN(0)) {
        LAS float* scr = (LAS float*)(lds + wave * 16384);
        constexpr int I_IN = (D / 64) * (DIN / 32), I_A = (D / 64) * (D / 32), I_GL = (DSSM / 64) * (D / 32), I_UP = (D / 64) * (DFF / 32), I_DN = (DFF / 64) * (D / 32);
        constexpr int NITEMS = I_IN + 2 * I_A + 2 * I_GL + I_UP + I_DN;
        for (int it = gw; it < NITEMS; it += NGW) {
            int r = it;
            if (r < I_IN) { p0_transpose_item(a.in[I_WIN], D, DIN, Wt_in, 0, scr, r, lane); continue; } r -= I_IN;
            if (r < I_A) { p0_transpose_item(a.in[I_WAOUT], D, D, Wt_a, 0, scr, r, lane); continue; } r -= I_A;
            if (r < I_GL) { p0_transpose_item(a.in[I_GLUW], DSSM, D, Wt_glu, 1, scr, r, lane); continue; } r -= I_GL;
            if (r < I_GL) { p0_transpose_item(a.in[I_GLUV], DSSM, D, Wt_glu, 2, scr, r, lane); continue; } r -= I_GL;
            if (r < I_A) { p0_transpose_item(a.in[I_WOUT], D, D, Wt_out, 0, scr, r, lane); continue; } r -= I_A;
            if (r < I_UP) { p0_transpose_item(a.in[I_WUP], D, DFF, Wt_up, 0, scr, r, lane); continue; } r -= I_UP;
            p0_transpose_item(a.in[I_WDOWN], DFF, D, Wt_down, 0, scr, r, lane);
        }
        {
            const float* x = a.in[I_X]; const size_t n8 = (size_t)M * D / 8;
            for (size_t i = (size_t)bx * NTHREADS + tid; i < n8; i += (size_t)G * NTHREADS) {
                const f32x4 v0 = *((const f32x4*)x + 2 * i), v1 = *((const f32x4*)x + 2 * i + 1);
                u32x4 w; w.x = pk2(v0.x, v0.y); w.y = pk2(v0.z, v0.w); w.z = pk2(v1.x, v1.y); w.w = pk2(v1.z, v1.w);
                *((u32x4*)XB + i) = w; }
        }
        for (int idx = bx * NTHREADS + tid; idx < 16 * 4 * 2 * 8 * 64; idx += G * NTHREADS) scan::rglru_pack_weights(a.in[I_WA], a.in[I_WX], (bf16_t*)(ws + WS_RGW), idx);
        {
            const int idx = bx * NTHREADS + tid;
            if (idx < NG * NP) {
                float2* lam = (float2*)(ws + WS_S5LAM); float* bbr = (float*)(ws + WS_S5BBR); float* bbi = (float*)(ws + WS_S5BBI);
                const int g = idx / NP;
                const double dt = exp((double)a.in[I_LOGDT][g]);
                const double lr = fmin((double)a.in[I_ARE][idx], -1e-4), li = (double)a.in[I_AIM][idx];
                const double mag = exp(lr * dt), lbr = mag * cos(li * dt), lbi = mag * sin(li * dt);
                const double zr = lbr - 1.0, zi = lbi, den = lr * lr + li * li;
                const double fr = (zr * lr + zi * li) / den, fi = (zi * lr - zr * li) / den;
                lam[idx] = make_float2((float)lbr, (float)lbi);
                for (int h = 0; h < GS; ++h) { const double br = a.in[I_BRE][idx * GS + h], bi = a.in[I_BIM][idx * GS + h];
                    bbr[idx * GS + h] = (float)(fr * br - fi * bi); bbi[idx * GS + h] = (float)(fr * bi + fi * br); }
            }
        }
        __syncthreads();
    }
    SEAM(0);
    if (IN(1)) { pg8::Gemm g{XB, D, Wt_in, D, M, DIN, D}; pg8::StaticOrder S; S.init(M, DIN, G, bx); pg8::gemm_phase(lds, g, S, pg8::EpiZ{Z}); if (DUP(1)) pg8::gemm_phase(lds, g, S, pg8::EpiZ{Z}); }
    SEAM(1);
    {
        const float2* lamtab = (const float2*)(ws + WS_S5LAM); const float* bbr = (const float*)(ws + WS_S5BBR); const float* bbi = (const float*)(ws + WS_S5BBI);
        const bf16_t* RGW = (const bf16_t*)(ws + WS_RGW); float *RGP = (float*)(ws + scan::WS_RGP), *RGS = (float*)(ws + scan::WS_RGS), *RGH = (float*)(ws + scan::WS_RGH), *S5S = (float*)(ws + scan::WS_S5S), *S5H = (float*)(ws + scan::WS_S5H);
        if (IN(2)) {
            scan::rglru_pass<false>(lds, Z, a.in[I_CONVW], a.in[I_CONVB], RGW, a.in[I_BA], a.in[I_BX], a.in[I_LAM], RGP, RGS, RGH, bx, G);
            scan::s5_pass<false>(Z, lamtab, bbr, bbi, a.in[I_CRE], a.in[I_CIM], a.in[I_SD], S5S, S5H, (LAS scan::f32x2v*)(lds + 114688 + wave * 512), gw, NGW, lane);
            if (DUP(2)) { __syncthreads(); scan::rglru_pass<false>(lds, Z, a.in[I_CONVW], a.in[I_CONVB], RGW, a.in[I_BA], a.in[I_BX], a.in[I_LAM], RGP, RGS, RGH, bx, G); }
            if (DUP(12)) { scan::s5_pass<false>(Z, lamtab, bbr, bbi, a.in[I_CRE], a.in[I_CIM], a.in[I_SD], S5S, S5H, (LAS scan::f32x2v*)(lds + 114688 + wave * 512), gw, NGW, lane); }
        }
        SEAM(2);
        if (IN(3)) {
            if (tid < 48) for (int idx = bx * 48 + tid; idx < NB * NG * NP + NB * D; idx += G * 48) {
                if (idx < NB * NG * NP) scan::s5_carry(lamtab, S5S, S5H, idx); else scan::rglru_carry(RGP, RGS, RGH, idx - NB * NG * NP); }
            if (DUP(3)) { if (tid < 48) for (int idx = bx * 48 + tid; idx < NB * NG * NP + NB * D; idx += G * 48) {
                if (idx < NB * NG * NP) scan::s5_carry(lamtab, S5S, S5H, idx); else scan::rglru_carry(RGP, RGS, RGH, idx - NB * NG * NP); } }
        }
        SEAM(3);
        if (IN(4)) {
            scan::rglru_pass<true>(lds, Z, a.in[I_CONVW], a.in[I_CONVB], RGW, a.in[I_BA], a.in[I_BX], a.in[I_LAM], RGP, RGS, RGH, bx, G);
            scan::s5_pass<true>(Z, lamtab, bbr, bbi, a.in[I_CRE], a.in[I_CIM], a.in[I_SD], S5S, S5H, (LAS scan::f32x2v*)(lds + 114688 + wave * 512), gw, NGW, lane);
        }
        SEAM(4);
    }
    if (IN(5)) { pg8::Gemm g{Z + O_U, DIN, Wt_glu, DSSM, M, 2 * D, DSSM}; pg8::StaticOrder S; S.init(M, 2 * D, G, bx); pg8::gemm_phase(lds, g, S, pg8::EpiGlu{Z}); }
    SEAM(5);
    if (IN(6)) { pg8::Gemm g{Z + O_GR, DIN, Wt_a, D, M, D, D}; pg8::StaticOrder S; S.init(M, D, G, bx); pg8::gemm_phase(lds, g, S, pg8::EpiMix{Z}); }
    SEAM(6);
    if (IN(7)) { pg8::Gemm g{Z + O_GA, DIN, Wt_out, D, M, D, D}; pg8::StaticOrder S; S.init(M, D, G, bx); pg8::gemm_phase(lds, g, S, pg8::EpiR1{a.in[I_X], a.out}); if (DUP(7)) pg8::gemm_phase(lds, g, S, pg8::EpiR1{a.in[I_X], a.out}); }
    SEAM(7);
    if (IN(8)) { for (int m = gw; m < M; m += NGW) ln_row(a.out + (size_t)m * D, a.in[I_LN1G], a.in[I_LN1B], X1B + (size_t)m * D, lane); }
    SEAM(8);
    if (IN(9)) { pg8::Gemm g{X1B, D, Wt_up, D, M, DFF, D}; pg8::StaticOrder S; S.init(M, DFF, G, bx); pg8::gemm_phase(lds, g, S, pg8::EpiUp{HMID, a.in[I_BUP]}); if (DUP(9)) pg8::gemm_phase(lds, g, S, pg8::EpiUp{HMID, a.in[I_BUP]}); }
    SEAM(9);
    if (IN(10)) { pg8::Gemm g{HMID, DFF, Wt_down, DFF, M, D, DFF}; pg8::StaticOrder S; S.init(M, D, G, bx); pg8::gemm_phase(lds, g, S, pg8::EpiR2{a.out, a.in[I_BDOWN]}); }
    SEAM(10);
    if (IN(11)) { for (int m = gw; m < M; m += NGW) ln_row(a.out + (size_t)m * D, a.in[I_LN2G], a.in[I_LN2B], nullptr, lane); }
#undef IN
#undef SEAM
}

#ifndef MK_SCAN_NAIVE
#define MK_SCAN_NAIVE 0
#endif
static hipError_t launch_mk(Args& a, int lo, int hi, int grid, hipStream_t stream) {
    a.ph_lo = lo; a.ph_hi = hi; void* args[] = {&a};
    return hipLaunchCooperativeKernel((const void*)mk_fwd, dim3(grid), dim3(NTHREADS), args, LDS_BYTES, stream);
}
extern "C" void kernel_launch(void* const* d_in, const int* in_sizes, int n_in, void* d_out, int out_size, void* d_ws, size_t ws_size, hipStream_t stream) {
    static int grid = 0;
    if (grid == 0) {
        if (n_in != N_IN || out_size != M * D || ws_size < WS_END) { fprintf(stderr, "kernel_launch: unexpected shapes (n_in %d out %d ws %zu)\n", n_in, out_size, ws_size); grid = -1; return; }
        int dev = 0, cus = 0, per_cu = 0;
        if (hipGetDevice(&dev) != hipSuccess || hipDeviceGetAttribute(&cus, hipDeviceAttributeMultiprocessorCount, dev) != hipSuccess) { grid = -1; return; }
        if (hipFuncSetAttribute((const void*)mk_fwd, hipFuncAttributeMaxDynamicSharedMemorySize, LDS_BYTES) != hipSuccess) { fprintf(stderr, "kernel_launch: hipFuncSetAttribute failed\n"); grid = -1; return; }
        if (hipOccupancyMaxActiveBlocksPerMultiprocessor(&per_cu, (const void*)mk_fwd, NTHREADS, LDS_BYTES) != hipSuccess || per_cu < 1) { fprintf(stderr, "kernel_launch: occupancy query says %d\n", per_cu); grid = -1; return; }
        grid = cus;
#if MK_SCAN_NAIVE
        (void)hipFuncSetAttribute((const void*)nv::k_rglru, hipFuncAttributeMaxDynamicSharedMemorySize, (2 * HD * HD + HD) * 4);
#endif
    }
    if (grid < 0) return;
    Args a{};
    for (int i = 0; i < N_IN; ++i) a.in[i] = (const float*)d_in[i];
    a.out = (float*)d_out; a.ws = (unsigned char*)d_ws;
    hipError_t e;
    if (hipMemsetAsync((char*)d_ws + WS_CTL, 0, 16384, stream) != hipSuccess) { fprintf(stderr, "kernel_launch: memset of the barrier words failed\n"); return; }
#if MK_SCAN_NAIVE
    unsigned char* ws = (unsigned char*)d_ws; bf16_t* Z = (bf16_t*)(ws + WS_Z);
    e = launch_mk(a, 0, 2, grid, stream);
    nv::k_rglru<<<NB * HEADS, 128, (2 * HD * HD + HD) * 4, stream>>>(Z, a.in[I_CONVW], a.in[I_CONVB], a.in[I_WA], a.in[I_BA], a.in[I_WX], a.in[I_BX], a.in[I_LAM]);
    nv::k_s5<<<NB * NG, 64, 0, stream>>>(Z, (const float2*)(ws + WS_S5LAM), (const float*)(ws + WS_S5BBR), (const float*)(ws + WS_S5BBI), a.in[I_CRE], a.in[I_CIM], a.in[I_SD]);
    if (e == hipSuccess) e = launch_mk(a, 5, 12, grid, stream);
#else
    e = launch_mk(a, 0, 12, grid, stream);
#endif
    if (e != hipSuccess) fprintf(stderr, "kernel_launch: cooperative launch failed: %s (grid %d)\n", hipGetErrorString(e), grid);
}
```

```cpp
#include <hip/hip_runtime.h>
#include <hip/hip_cooperative_groups.h>
#include <cstdio>
#include <cstdint>

typedef unsigned short bf16_t;
constexpr int NB = 2, SEQ = 8192, M = NB * SEQ, D = 2048, HEADS = 16, HD = 128, DSSM = 1024, NG = 64, GS = 16, NP = 64, DFF = 8192, DIN = 9216;
constexpr int O_XR = 0, O_GR = 2048, O_U = 4096, O_GA = 5120, O_GB = 7168;
constexpr float ALPHA = 1.189207115002721f;
constexpr float LN_EPS = 1e-5f;
enum { I_X = 0, I_WIN, I_CONVW, I_CONVB, I_WA, I_BA, I_WX, I_BX, I_LAM, I_WAOUT, I_ARE, I_AIM, I_LOGDT, I_BRE, I_BIM, I_CRE, I_CIM, I_SD, I_GLUW, I_GLUV, I_WOUT,
       I_LN1G, I_LN1B, I_WUP, I_BUP, I_WDOWN, I_BDOWN, I_LN2G, I_LN2B, N_IN };

constexpr size_t MiB = 1u << 20;
constexpr size_t WS_CTL = 0;
constexpr size_t WS_S5LAM = 1 * MiB;
constexpr size_t WS_S5BBR = WS_S5LAM + 64 * 1024;
constexpr size_t WS_S5BBI = WS_S5BBR + 256 * 1024;
constexpr size_t WS_WIN = 2 * MiB;
constexpr size_t WS_WA = WS_WIN + 36 * MiB;
constexpr size_t WS_WGLU = WS_WA + 8 * MiB;
constexpr size_t WS_WOUT = WS_WGLU + 8 * MiB;
constexpr size_t WS_WUP = WS_WOUT + 8 * MiB;
constexpr size_t WS_WDOWN = WS_WUP + 32 * MiB;
constexpr size_t WS_X1B = WS_WDOWN + 32 * MiB;
constexpr size_t WS_Z = WS_X1B + 64 * MiB;
constexpr size_t WS_RGW = WS_Z + 288 * MiB;
constexpr size_t WS_END = WS_RGW + 1 * MiB;

__device__ __forceinline__ bf16_t f2bf(float f) { unsigned u = __float_as_uint(f); u += 0x7fffu + ((u >> 16) & 1u); return (bf16_t)(u >> 16); }
__device__ __forceinline__ float bf2f(bf16_t b) { return __uint_as_float(((unsigned)b) << 16); }
__device__ __forceinline__ float sigmoid_f(float x) { return 1.f / (1.f + __expf(-x)); }
__device__ __forceinline__ float gelu_tanh(float x) { const float u = 1.5957691216057308f * (x + 0.044715f * x * x * x); return x * sigmoid_f(u); }

namespace nv {
__device__ __forceinline__ int rowmap(int mode, int n) { return mode == 0 ? n : ((n >> 7) * 256 + (mode == 2 ? 128 : 0) + (n & 127)); }
__global__ void k_transpose(const float* __restrict__ W, int K, int N, bf16_t* __restrict__ Wt, int mode) {
    __shared__ float tile[32][33];
    const int n0 = blockIdx.x * 32, k0 = blockIdx.y * 32;
    for (int i = threadIdx.y; i < 32; i += 8) tile[i][threadIdx.x] = W[(size_t)(k0 + i) * N + n0 + threadIdx.x];
    __syncthreads();
    for (int i = threadIdx.y; i < 32; i += 8) { const int row = rowmap(mode, n0 + i); Wt[(size_t)row * K + k0 + threadIdx.x] = f2bf(tile[threadIdx.x][i]); }
}
__global__ void k_cvt(const float* __restrict__ x, bf16_t* __restrict__ xb, size_t n) {
    for (size_t i = (size_t)blockIdx.x * blockDim.x + threadIdx.x; i < n; i += (size_t)gridDim.x * blockDim.x) xb[i] = f2bf(x[i]);
}
__global__ void k_s5_params(const float* a_re, const float* a_im, const float* log_dt, const float* b_re, const float* b_im, float2* lam, float* bbr, float* bbi) {
    const int idx = blockIdx.x * blockDim.x + threadIdx.x; if (idx >= NG * NP) return;
    const int g = idx / NP;
    const double dt = exp((double)log_dt[g]);
    const double lr = fmin((double)a_re[idx], -1e-4), li = (double)a_im[idx];
    const double mag = exp(lr * dt), lbr = mag * cos(li * dt), lbi = mag * sin(li * dt);
    const double zr = lbr - 1.0, zi = lbi, den = lr * lr + li * li;
    const double fr = (zr * lr + zi * li) / den, fi = (zi * lr - zr * li) / den;
    lam[idx] = make_float2((float)lbr, (float)lbi);
    for (int h = 0; h < GS; ++h) { const double br = b_re[idx * GS + h], bi = b_im[idx * GS + h];
        bbr[idx * GS + h] = (float)(fr * br - fi * bi); bbi[idx * GS + h] = (float)(fr * bi + fi * br); }
}
template <class Epi> __global__ void __launch_bounds__(256) k_gemm(const bf16_t* __restrict__ A, int lda, const bf16_t* __restrict__ Bt, int ldb, int K, Epi E) {
    __shared__ float As[16][68], Bs[16][68];
    const int tid = threadIdx.x, tx = tid & 15, ty = tid >> 4, m0 = blockIdx.y * 64, n0 = blockIdx.x * 64;
    float acc[4][4];
#pragma unroll
    for (int i = 0; i < 4; ++i)
#pragma unroll
        for (int j = 0; j < 4; ++j) acc[i][j] = 0.f;
    const int lr = tid >> 2, lk = (tid & 3) * 4;
    for (int k0 = 0; k0 < K; k0 += 16) {
        const ushort4 av = *(const ushort4*)(A + (size_t)(m0 + lr) * lda + k0 + lk);
        const ushort4 bv = *(const ushort4*)(Bt + (size_t)(n0 + lr) * ldb + k0 + lk);
        As[lk + 0][lr] = bf2f(av.x); As[lk + 1][lr] = bf2f(av.y); As[lk + 2][lr] = bf2f(av.z); As[lk + 3][lr] = bf2f(av.w);
        Bs[lk + 0][lr] = bf2f(bv.x); Bs[lk + 1][lr] = bf2f(bv.y); Bs[lk + 2][lr] = bf2f(bv.z); Bs[lk + 3][lr] = bf2f(bv.w);
        __syncthreads();
#pragma unroll
        for (int k = 0; k < 16; ++k) {
            const float4 a = *(const float4*)&As[k][ty * 4], b = *(const float4*)&Bs[k][tx * 4];
            const float aa[4] = {a.x, a.y, a.z, a.w}, bb[4] = {b.x, b.y, b.z, b.w};
#pragma unroll
            for (int i = 0; i < 4; ++i)
#pragma unroll
                for (int j = 0; j < 4; ++j) acc[i][j] += aa[i] * bb[j];
        }
        __syncthreads();
    }
#pragma unroll
    for (int i = 0; i < 4; ++i)
#pragma unroll
        for (int j = 0; j < 4; ++j) E(m0 + ty * 4 + i, n0 + tx * 4 + j, acc[i][j]);
}
__global__ void __launch_bounds__(256) k_glu(const bf16_t* __restrict__ A, int lda, const bf16_t* __restrict__ Bt, int K, bf16_t* Z) {
    __shared__ float As[16][68], Bw[16][68], Bv[16][68];
    const int tid = threadIdx.x, tx = tid & 15, ty = tid >> 4, m0 = blockIdx.y * 64, n0 = blockIdx.x * 64;
    float aw[4][4], avv[4][4];
#pragma unroll
    for (int i = 0; i < 4; ++i)
#pragma unroll
        for (int j = 0; j < 4; ++j) { aw[i][j] = 0.f; avv[i][j] = 0.f; }
    const int lr = tid >> 2, lk = (tid & 3) * 4;
    const int rw = rowmap(1, n0 + lr), rv = rowmap(2, n0 + lr);
    for (int k0 = 0; k0 < K; k0 += 16) {
        const ushort4 a4 = *(const ushort4*)(A + (size_t)(m0 + lr) * lda + k0 + lk);
        const ushort4 w4 = *(const ushort4*)(Bt + (size_t)rw * K + k0 + lk);
        const ushort4 v4 = *(const ushort4*)(Bt + (size_t)rv * K + k0 + lk);
        As[lk + 0][lr] = bf2f(a4.x); As[lk + 1][lr] = bf2f(a4.y); As[lk + 2][lr] = bf2f(a4.z); As[lk + 3][lr] = bf2f(a4.w);
        Bw[lk + 0][lr] = bf2f(w4.x); Bw[lk + 1][lr] = bf2f(w4.y); Bw[lk + 2][lr] = bf2f(w4.z); Bw[lk + 3][lr] = bf2f(w4.w);
        Bv[lk + 0][lr] = bf2f(v4.x); Bv[lk + 1][lr] = bf2f(v4.y); Bv[lk + 2][lr] = bf2f(v4.z); Bv[lk + 3][lr] = bf2f(v4.w);
        __syncthreads();
#pragma unroll
        for (int k = 0; k < 16; ++k) {
            const float4 a = *(const float4*)&As[k][ty * 4], w = *(const float4*)&Bw[k][tx * 4], v = *(const float4*)&Bv[k][tx * 4];
            const float aa[4] = {a.x, a.y, a.z, a.w}, ww[4] = {w.x, w.y, w.z, w.w}, vv[4] = {v.x, v.y, v.z, v.w};
#pragma unroll
            for (int i = 0; i < 4; ++i)
#pragma unroll
                for (int j = 0; j < 4; ++j) { aw[i][j] += aa[i] * ww[j]; avv[i][j] += aa[i] * vv[j]; }
        }
        __syncthreads();
    }
#pragma unroll
    for (int i = 0; i < 4; ++i)
#pragma unroll
        for (int j = 0; j < 4; ++j) { const int row = m0 + ty * 4 + i, col = n0 + tx * 4 + j; bf16_t* p = Z + (size_t)row * DIN + O_GB + col;
            *p = f2bf(aw[i][j] * sigmoid_f(avv[i][j]) * bf2f(*p)); }
}
__global__ void __launch_bounds__(128) k_rglru(bf16_t* Z, const float* conv_w, const float* conv_b, const float* wa, const float* ba, const float* wx, const float* bx, const float* lam) {
    extern __shared__ float sm[];
    float* s_wa = sm; float* s_wx = sm + HD * HD; float* s_xc = sm + 2 * HD * HD;
    const int b = blockIdx.x / HEADS, hd = blockIdx.x % HEADS, j = threadIdx.x, ch = hd * HD + j;
    for (int i = j; i < HD * HD; i += 128) { s_wa[i] = wa[(size_t)hd * HD * HD + i]; s_wx[i] = wx[(size_t)hd * HD * HD + i]; }
    const float cw0 = conv_w[0 * D + ch], cw1 = conv_w[1 * D + ch], cw2 = conv_w[2 * D + ch], cw3 = conv_w[3 * D + ch], cb = conv_b[ch];
    const float bav = ba[ch], bxv = bx[ch];
    const float lac = -8.f * log1pf(expf(-lam[ch]));
    float x1 = 0.f, x2 = 0.f, x3 = 0.f, h = 0.f;
    __syncthreads();
    bf16_t* zr = Z + (size_t)b * SEQ * DIN;
    for (int t = 0; t < SEQ; ++t) {
        const float x0 = bf2f(zr[(size_t)t * DIN + O_XR + ch]);
        const float xc = cw0 * x3 + cw1 * x2 + cw2 * x1 + cw3 * x0 + cb;
        x3 = x2; x2 = x1; x1 = x0;
        s_xc[j] = xc;
        __syncthreads();
        float rp = bav, ip = bxv;
#pragma unroll 8
        for (int i = 0; i < HD; ++i) { const float v = s_xc[i]; rp += v * s_wa[i * HD + j]; ip += v * s_wx[i * HD + j]; }
        __syncthreads();
        const float r = sigmoid_f(rp), ig = sigmoid_f(ip);
        const float la = r * lac, a = expf(la), mult = sqrtf(-expm1f(2.f * la));
        h = a * h + mult * (ig * xc);
        bf16_t* g = zr + (size_t)t * DIN + O_GR + ch;
        *g = f2bf(h * bf2f(*g));
    }
}
__global__ void __launch_bounds__(64) k_s5(bf16_t* Z, const float2* lamb, const float* bbr, const float* bbi, const float* c_re, const float* c_im, const float* dd) {
    const int b = blockIdx.x / NG, g = blockIdx.x % NG, p = threadIdx.x;
    float br[GS], bi[GS], cr[GS], ci[GS];
#pragma unroll
    for (int h = 0; h < GS; ++h) { br[h] = bbr[(g * NP + p) * GS + h]; bi[h] = bbi[(g * NP + p) * GS + h]; cr[h] = c_re[(g * GS + h) * NP + p]; ci[h] = c_im[(g * GS + h) * NP + p]; }
    const float2 l = lamb[g * NP + p];
    const float dv = dd[g * GS + (p & 15)];
    float hr = 0.f, hi = 0.f;
    bf16_t* zr = Z + (size_t)b * SEQ * DIN + O_U + g * GS;
    for (int t = 0; t < SEQ; ++t) {
        const float ul = bf2f(zr[(size_t)t * DIN + (p & 15)]);
        float bur = 0.f, bui = 0.f;
#pragma unroll
        for (int h = 0; h < GS; ++h) { const float u = __shfl(ul, h); bur += br[h] * u; bui += bi[h] * u; }
        const float nr = l.x * hr - l.y * hi + bur, ni = l.x * hi + l.y * hr + bui; hr = nr; hi = ni;
        float yv = 0.f;
#pragma unroll
        for (int h = 0; h < GS; ++h) { float v = cr[h] * hr - ci[h] * hi;
#pragma unroll
            for (int o = 1; o < 64; o <<= 1) v += __shfl_xor(v, o);
            yv = (p == h) ? v : yv; }
        if (p < GS) zr[(size_t)t * DIN + p] = f2bf(gelu_tanh(yv + dv * ul));
    }
}
__global__ void __launch_bounds__(256) k_ln(float* X, const float* g, const float* bt, bf16_t* xb) {
    __shared__ float red[8];
    const int row = blockIdx.x, tid = threadIdx.x; float* xr = X + (size_t)row * D;
    float v[8]; float s = 0.f;
#pragma unroll
    for (int i = 0; i < 8; ++i) { v[i] = xr[tid + 256 * i]; s += v[i]; }
#pragma unroll
    for (int o = 1; o < 64; o <<= 1) s += __shfl_xor(s, o);
    if ((tid & 63) == 0) red[tid >> 6] = s;
    __syncthreads();
    const float mean = (red[0] + red[1] + red[2] + red[3]) * (1.f / D);
    float q = 0.f;
#pragma unroll
    for (int i = 0; i < 8; ++i) { v[i] -= mean; q += v[i] * v[i]; }
#pragma unroll
    for (int o = 1; o < 64; o <<= 1) q += __shfl_xor(q, o);
    if ((tid & 63) == 0) red[4 + (tid >> 6)] = q;
    __syncthreads();
    const float rstd = rsqrtf((red[4] + red[5] + red[6] + red[7]) * (1.f / D) + LN_EPS);
#pragma unroll
    for (int i = 0; i < 8; ++i) { const int c = tid + 256 * i; const float y = v[i] * rstd * g[c] + bt[c]; xr[c] = y; if (xb) xb[(size_t)row * D + c] = f2bf(y); }
}
struct EpiZ { bf16_t* Z; __device__ void operator()(int r, int c, float a) const {
    float v = a; if (c >= O_GR && c < O_U) v = gelu_tanh(a); else if (c >= O_GA) v = sigmoid_f(a); Z[(size_t)r * DIN + c] = f2bf(v); } };
struct EpiMix { bf16_t* Z; __device__ void operator()(int r, int c, float a) const {
    bf16_t* p = Z + (size_t)r * DIN + O_GA + c; *p = f2bf(bf2f(*p) * a + bf2f(Z[(size_t)r * DIN + O_GB + c])); } };
struct EpiR1 { const float* x; float* out; __device__ void operator()(int r, int c, float a) const { out[(size_t)r * D + c] = ALPHA * x[(size_t)r * D + c] + a; } };
struct EpiUp { bf16_t* H; const float* b; __device__ void operator()(int r, int c, float a) const { const float v = fmaxf(a + b[c], 0.f); H[(size_t)r * DFF + c] = f2bf(v * v); } };
struct EpiR2 { float* out; const float* b; __device__ void operator()(int r, int c, float a) const { float* p = out + (size_t)r * D + c; *p = ALPHA * (*p) + a + b[c]; } };
}

__device__ __forceinline__ int fresh_tid(int wave_s) { unsigned m = ~0u; asm volatile("" : "+s"(m)); return wave_s * 64 + (int)__builtin_amdgcn_mbcnt_hi(m, __builtin_amdgcn_mbcnt_lo(m, 0u)); }
namespace pg8 {
#define PG8_LAS __attribute__((address_space(3)))
typedef short bf16x8 __attribute__((ext_vector_type(8)));
typedef float f32x4 __attribute__((ext_vector_type(4)));
typedef unsigned u32x4 __attribute__((ext_vector_type(4)));
typedef unsigned u32x2 __attribute__((ext_vector_type(2)));
constexpr int BM = 256, BK = 64, HALF = 128, HTB = HALF * BK * 2  , STAGE_BYTES = 8 * HTB, NXCD = 8, WGM = 8;
__host__ __device__ __forceinline__ int lds_byte(int r, int c) { const int st = (r >> 4) * 2 + (c >> 5), rr = r & 15, cc = c & 31, ob = rr * 64 + cc * 2; return st * 1024 + (ob ^ (((ob >> 9) & 1) << 5)); }
__host__ __device__ __forceinline__ void stage_rc(int b, int& R, int& C) { const int st = b / 1024, sb = b % 1024, swz = sb ^ (((sb >> 9) & 1) << 5); R = (st >> 1) * 16 + swz / 64; C = (st & 1) * 32 + (swz % 64) / 2; }
__host__ __device__ __forceinline__ int perm32(int rho) { const int n = rho >> 4, i = rho & 15; return 8 * (i >> 2) + 4 * n + (i & 3); }
struct Unit { int pm, pn; };
struct Gemm { const bf16_t* A; int lda; const bf16_t* Bt; int ldb; int M, N, K; };
struct StaticOrder {
    int nM, nN, nwg, G, c;
    __host__ __device__ void init(int M_, int N_, int G_, int c_) { nM = M_ / BM; nN = N_ / BM; nwg = nM * nN; G = G_; c = c_; }
    __host__ __device__ bool next(int i, Unit& u) const {
        const long L = (long)i * G + c; if (L >= nwg) return false;
        int wgid = (int)L; { const int q = nwg / NXCD, r = nwg % NXCD, xcd = wgid % NXCD, off = wgid / NXCD; wgid = (xcd < r ? xcd * (q + 1) : r * (q + 1) + (xcd - r) * q) + off; }
        const int nig = WGM * nN, gid = wgid / nig, fm = gid * WGM, gsz = (nM - fm) < WGM ? (nM - fm) : WGM;
        u.pm = fm + ((wgid % nig) % gsz); u.pn = (wgid % nig) / gsz; return true;
    }
    __device__ __forceinline__ void a_ready(const Unit&) const {}
    __device__ __forceinline__ void done(const Unit&) const {}
};
__device__ __forceinline__ unsigned cvt_pk_bf16(float lo, float hi) { unsigned r; asm volatile("v_cvt_pk_bf16_f32 %0, %1, %2" : "=v"(r) : "v"(lo), "v"(hi)); return r; }
__device__ __forceinline__ float bf_lo(unsigned w) { return __uint_as_float(w << 16); }
__device__ __forceinline__ float bf_hi(unsigned w) { return __uint_as_float(w & 0xffff0000u); }
__device__ __forceinline__ float sigm(float x) { return __builtin_amdgcn_rcpf(1.f + __expf(-x)); }
__device__ __forceinline__ float gelu_t(float x) { const float u = 1.5957691216057308f * (x + 0.044715f * x * x * x); return x * sigm(u); }

struct EpiZ {
    static constexpr bool PERM = true, AFTER_DRAIN = false, IDEMP = true;
    bf16_t* Z;
    __device__ __forceinline__ void operator()(const f32x4 (&acc)[2][2][4][2], const Unit& u, int wr, int wc, int fr, int fq) const {
        const int row0 = u.pm * BM + wr * 64 + fr, col0 = u.pn * BM + wc * 32 + 8 * fq;
        const int act = (u.pn >= 20) ? 2 : ((u.pn >= 8 && u.pn < 16) ? 1 : 0);
#pragma unroll
        for (int ai = 0; ai < 2; ++ai)
#pragma unroll
            for (int m = 0; m < 4; ++m) { bf16_t* rowp = Z + (size_t)(row0 + ai * HALF + m * 16) * DIN + col0;
#pragma unroll
                for (int bj = 0; bj < 2; ++bj) { f32x4 v0 = acc[ai][bj][m][0], v1 = acc[ai][bj][m][1];
                    if (act == 1) {
#pragma unroll
                        for (int j = 0; j < 4; ++j) { v0[j] = gelu_t(v0[j]); v1[j] = gelu_t(v1[j]); } }
                    else if (act == 2) {
#pragma unroll
                        for (int j = 0; j < 4; ++j) { v0[j] = sigm(v0[j]); v1[j] = sigm(v1[j]); } }
                    u32x4 w; w.x = cvt_pk_bf16(v0[0], v0[1]); w.y = cvt_pk_bf16(v0[2], v0[3]); w.z = cvt_pk_bf16(v1[0], v1[1]); w.w = cvt_pk_bf16(v1[2], v1[3]);
                    *(u32x4*)(rowp + bj * HALF) = w; } }
    }
};
struct EpiGlu {
    static constexpr bool PERM = true, AFTER_DRAIN = false, IDEMP = false;
    bf16_t* Z;
    __device__ __forceinline__ void operator()(const f32x4 (&acc)[2][2][4][2], const Unit& u, int wr, int wc, int fr, int fq) const {
        const int row0 = u.pm * BM + wr * 64 + fr, col0 = u.pn * HALF + wc * 32 + 8 * fq;
#pragma unroll
        for (int ai = 0; ai < 2; ++ai)
#pragma unroll
            for (int m = 0; m < 4; ++m) { bf16_t* p = Z + (size_t)(row0 + ai * HALF + m * 16) * DIN + O_GB + col0;
                const u32x4 g = *(const u32x4*)p;
                const f32x4 w0 = acc[ai][0][m][0], w1 = acc[ai][0][m][1], v0 = acc[ai][1][m][0], v1 = acc[ai][1][m][1];
                u32x4 o;
                o.x = cvt_pk_bf16(w0[0] * sigm(v0[0]) * bf_lo(g.x), w0[1] * sigm(v0[1]) * bf_hi(g.x));
                o.y = cvt_pk_bf16(w0[2] * sigm(v0[2]) * bf_lo(g.y), w0[3] * sigm(v0[3]) * bf_hi(g.y));
                o.z = cvt_pk_bf16(w1[0] * sigm(v1[0]) * bf_lo(g.z), w1[1] * sigm(v1[1]) * bf_hi(g.z));
                o.w = cvt_pk_bf16(w1[2] * sigm(v1[2]) * bf_lo(g.w), w1[3] * sigm(v1[3]) * bf_hi(g.w));
                *(u32x4*)p = o; }
    }
};
struct EpiMix {
    static constexpr bool PERM = true, AFTER_DRAIN = false, IDEMP = false;
    bf16_t* Z;
    __device__ __forceinline__ void operator()(const f32x4 (&acc)[2][2][4][2], const Unit& u, int wr, int wc, int fr, int fq) const {
        const int row0 = u.pm * BM + wr * 64 + fr, col0 = u.pn * BM + wc * 32 + 8 * fq;
#pragma unroll
        for (int ai = 0; ai < 2; ++ai)
#pragma unroll
            for (int m = 0; m < 4; ++m) { bf16_t* rowp = Z + (size_t)(row0 + ai * HALF + m * 16) * DIN + col0;
#pragma unroll
                for (int bj = 0; bj < 2; ++bj) { bf16_t* pa = rowp + O_GA + bj * HALF; const bf16_t* pb = rowp + O_GB + bj * HALF;
                    const u32x4 ga = *(const u32x4*)pa, yb = *(const u32x4*)pb; const f32x4 a0 = acc[ai][bj][m][0], a1 = acc[ai][bj][m][1];
                    u32x4 o;
                    o.x = cvt_pk_bf16(bf_lo(ga.x) * a0[0] + bf_lo(yb.x), bf_hi(ga.x) * a0[1] + bf_hi(yb.x));
                    o.y = cvt_pk_bf16(bf_lo(ga.y) * a0[2] + bf_lo(yb.y), bf_hi(ga.y) * a0[3] + bf_hi(yb.y));
                    o.z = cvt_pk_bf16(bf_lo(ga.z) * a1[0] + bf_lo(yb.z), bf_hi(ga.z) * a1[1] + bf_hi(yb.z));
                    o.w = cvt_pk_bf16(bf_lo(ga.w) * a1[2] + bf_lo(yb.w), bf_hi(ga.w) * a1[3] + bf_hi(yb.w));
                    *(u32x4*)pa = o; } }
    }
};
struct EpiR1 {
    static constexpr bool PERM = false, AFTER_DRAIN = false, IDEMP = true;
    const float* x; float* out;
    __device__ __forceinline__ void operator()(const f32x4 (&acc)[2][2][4][2], const Unit& u, int wr, int wc, int fr, int fq) const {
        const int row0 = u.pm * BM + wr * 64 + fr, col0 = u.pn * BM + wc * 32 + 4 * fq;
#pragma unroll
        for (int ai = 0; ai < 2; ++ai)
#pragma unroll
            for (int m = 0; m < 4; ++m) { const size_t off = (size_t)(row0 + ai * HALF + m * 16) * D + col0;
#pragma unroll
                for (int bj = 0; bj < 2; ++bj)
#pragma unroll
                    for (int n = 0; n < 2; ++n) { const f32x4 xv = *(const f32x4*)(x + off + bj * HALF + n * 16); *(f32x4*)(out + off + bj * HALF + n * 16) = xv * ALPHA + acc[ai][bj][m][n]; }
                asm volatile("" ::: "memory"); }
    }
};
struct EpiUp {
    static constexpr bool PERM = true, AFTER_DRAIN = false, IDEMP = true;
    bf16_t* H; const float* bias;
    __device__ __forceinline__ void operator()(const f32x4 (&acc)[2][2][4][2], const Unit& u, int wr, int wc, int fr, int fq) const {
        const int row0 = u.pm * BM + wr * 64 + fr, col0 = u.pn * BM + wc * 32 + 8 * fq;
        f32x4 bv[2][2];
#pragma unroll
        for (int bj = 0; bj < 2; ++bj)
#pragma unroll
            for (int n = 0; n < 2; ++n) bv[bj][n] = *(const f32x4*)(bias + col0 + bj * HALF + 4 * n);
#pragma unroll
        for (int ai = 0; ai < 2; ++ai)
#pragma unroll
            for (int m = 0; m < 4; ++m) { bf16_t* rowp = H + (size_t)(row0 + ai * HALF + m * 16) * DFF + col0;
#pragma unroll
                for (int bj = 0; bj < 2; ++bj) { f32x4 v0 = acc[ai][bj][m][0] + bv[bj][0], v1 = acc[ai][bj][m][1] + bv[bj][1];
#pragma unroll
                    for (int j = 0; j < 4; ++j) { v0[j] = fmaxf(v0[j], 0.f); v0[j] *= v0[j]; v1[j] = fmaxf(v1[j], 0.f); v1[j] *= v1[j]; }
                    u32x4 w; w.x = cvt_pk_bf16(v0[0], v0[1]); w.y = cvt_pk_bf16(v0[2], v0[3]); w.z = cvt_pk_bf16(v1[0], v1[1]); w.w = cvt_pk_bf16(v1[2], v1[3]);
                    *(u32x4*)(rowp + bj * HALF) = w; } }
    }
};
struct EpiR2 {
    static constexpr bool PERM = false, AFTER_DRAIN = false, IDEMP = false;
    float* out; const float* bias;
    __device__ __forceinline__ void operator()(const f32x4 (&acc)[2][2][4][2], const Unit& u, int wr, int wc, int fr, int fq) const {
        const int row0 = u.pm * BM + wr * 64 + fr, col0 = u.pn * BM + wc * 32 + 4 * fq;
        f32x4 bv[2][2];
#pragma unroll
        for (int bj = 0; bj < 2; ++bj)
#pragma unroll
            for (int n = 0; n < 2; ++n) bv[bj][n] = *(const f32x4*)(bias + col0 + bj * HALF + n * 16);
#pragma unroll
        for (int ai = 0; ai < 2; ++ai)
#pragma unroll
            for (int m = 0; m < 4; ++m) { const size_t off = (size_t)(row0 + ai * HALF + m * 16) * D + col0;
#pragma unroll
                for (int bj = 0; bj < 2; ++bj)
#pragma unroll
                    for (int n = 0; n < 2; ++n) { float* p = out + off + bj * HALF + n * 16; const f32x4 xv = *(const f32x4*)p; *(f32x4*)p = xv * ALPHA + acc[ai][bj][m][n] + bv[bj][n]; }
                asm volatile("" ::: "memory"); }
    }
};

template <class Epi, class Sched, bool ALIGN_EPI = true>
__device__ __forceinline__ void gemm_phase(PG8_LAS unsigned char* lds, const Gemm g, const Sched& S, const Epi& E, int wave_s) {
    const int tid = fresh_tid(wave_s);
    const int wid = __builtin_amdgcn_readfirstlane(tid >> 6), lane = tid & 63, wr = wid >> 2, wc = wid & 3, fr = lane & 15, fq = lane >> 4;
    const int K = g.K, nt = K / BK;
    unsigned voffA[2], voffB[2];
#pragma unroll
    for (int i = 0; i < 2; ++i) { int R, C; stage_rc(tid * 16 + i * 8192, R, C); const int Rb = Epi::PERM ? ((R & ~31) + perm32(R & 31)) : R;
        voffA[i] = (unsigned)(R * g.lda + C) * 2u; voffB[i] = (unsigned)(Rb * g.ldb + C) * 2u; }
    const size_t kstep = (size_t)(BK * 2);
    const size_t hstepA = (size_t)HALF * g.lda * 2, hstepB = (size_t)HALF * g.ldb * 2;
    const size_t tstepA = 2 * hstepA, tstepB = 2 * hstepB;
    const unsigned ldsw = (unsigned)wid * 1024u;
    const int aoff = lds_byte(wr * 64 + fr, fq * 8), boff = lds_byte(wc * 32 + fr, fq * 8);
#define PG8_SA(b, h) (((b) * 2 + (h)) * HTB)
#define PG8_SB(b, h) ((4 + (b) * 2 + (h)) * HTB)
#define PG8_STAGE(bufoff, gbase, voff) do { _Pragma("unroll") for (int _i = 0; _i < 2; ++_i) \
        __builtin_amdgcn_global_load_lds((const unsigned*)((const char*)(gbase) + (voff)[_i]), (PG8_LAS unsigned*)(lds + (bufoff) + ldsw + _i * 8192), 16, 0, 0); } while (0)
#define PG8_LDA(dst, b, h) do { _Pragma("unroll") for (int m = 0; m < 4; ++m) _Pragma("unroll") for (int k = 0; k < 2; ++k) dst[m][k] = *(const PG8_LAS bf16x8*)(lds + PG8_SA(b, h) + aoff + m * 2048 + k * 1024); } while (0)
#define PG8_LDB(dst, b, h) do { _Pragma("unroll") for (int n = 0; n < 2; ++n) _Pragma("unroll") for (int k = 0; k < 2; ++k) dst[n][k] = *(const PG8_LAS bf16x8*)(lds + PG8_SB(b, h) + boff + n * 2048 + k * 1024); } while (0)
#define PG8_MMA(ai, bj, At, Bt) do { __builtin_amdgcn_s_setprio(1); _Pragma("unroll") for (int m = 0; m < 4; ++m) _Pragma("unroll") for (int n = 0; n < 2; ++n) _Pragma("unroll") for (int k = 0; k < 2; ++k) \
        acc[ai][bj][m][n] = __builtin_amdgcn_mfma_f32_16x16x32_bf16(Bt[n][k], At[m][k], acc[ai][bj][m][n], 0, 0, 0); __builtin_amdgcn_s_setprio(0); } while (0)
#define PG8_WAIT_V(n) asm volatile("s_waitcnt vmcnt(" #n ")" ::: "memory")
#define PG8_WAIT_L(n) asm volatile("s_waitcnt lgkmcnt(" #n ")" ::: "memory")
#define PG8_BAR __builtin_amdgcn_s_barrier()
#define PG8_SCHED __builtin_amdgcn_sched_barrier(0)
    Unit cur, nxt; int ui = 0;
    if (!S.next(0, cur)) return;
    f32x4 acc[2][2][4][2];
#pragma unroll
    for (int a = 0; a < 2; ++a)
#pragma unroll
        for (int b = 0; b < 2; ++b)
#pragma unroll
            for (int m = 0; m < 4; ++m)
#pragma unroll
                for (int n = 0; n < 2; ++n) acc[a][b][m][n] = (f32x4){0.f, 0.f, 0.f, 0.f};
    bf16x8 At[4][2], B0[2][2], B1[2][2];
    const char* cA = (const char*)g.A + (size_t)cur.pm * tstepA; const char* cB = (const char*)g.Bt + (size_t)cur.pn * tstepB;
    S.a_ready(cur);
    PG8_STAGE(PG8_SB(0, 0), cB, voffB); PG8_STAGE(PG8_SB(0, 1), cB + hstepB, voffB); PG8_STAGE(PG8_SA(0, 0), cA, voffA); PG8_STAGE(PG8_SA(0, 1), cA + hstepA, voffA);
    if (wr == 1) PG8_BAR;
    PG8_WAIT_V(2); PG8_BAR;
    PG8_STAGE(PG8_SB(1, 0), cB + kstep, voffB); PG8_STAGE(PG8_SA(1, 0), cA + kstep, voffA); PG8_STAGE(PG8_SB(1, 1), cB + hstepB + kstep, voffB);
    PG8_WAIT_V(6); PG8_BAR;
    for (;;) {
        const bool has_next = S.next(ui + 1, nxt);
        const char* nA = has_next ? (const char*)g.A + (size_t)nxt.pm * tstepA : cA; const char* nB = has_next ? (const char*)g.Bt + (size_t)nxt.pn * tstepB : cB;
        for (int t = 0; t < nt; t += 2) {
            const bool last = (t == nt - 2);
            const char* a1 = cA + (size_t)(t + 1) * kstep;
            const char* a2 = last ? nA : cA + (size_t)(t + 2) * kstep; const char* b2 = last ? nB : cB + (size_t)(t + 2) * kstep;
            const char* a3 = a2 + kstep; const char* b3 = b2 + kstep;
            if (last && has_next) S.a_ready(nxt);
            PG8_LDB(B0, 0, 0); PG8_LDB(B1, 0, 1); PG8_SCHED; PG8_LDA(At, 0, 0); PG8_STAGE(PG8_SA(1, 1), a1 + hstepA, voffA);
            PG8_WAIT_V(8); PG8_WAIT_L(0); PG8_BAR; PG8_MMA(0, 0, At, B0); PG8_MMA(0, 1, At, B1); PG8_BAR; PG8_SCHED;
            PG8_LDA(At, 0, 1); PG8_STAGE(PG8_SB(0, 0), b2, voffB); PG8_STAGE(PG8_SB(0, 1), b2 + hstepB, voffB); PG8_STAGE(PG8_SA(0, 0), a2, voffA);
            PG8_WAIT_V(8); PG8_WAIT_L(0); PG8_BAR; PG8_MMA(1, 0, At, B0); PG8_MMA(1, 1, At, B1); PG8_BAR; PG8_SCHED;
            PG8_LDB(B0, 1, 0); PG8_LDB(B1, 1, 1); PG8_SCHED; PG8_LDA(At, 1, 0); PG8_STAGE(PG8_SA(0, 1), a2 + hstepA, voffA);
            PG8_WAIT_V(8); PG8_WAIT_L(0); PG8_BAR; PG8_MMA(0, 0, At, B0); PG8_MMA(0, 1, At, B1); PG8_BAR; PG8_SCHED;
            PG8_LDA(At, 1, 1); PG8_STAGE(PG8_SB(1, 0), b3, voffB); PG8_STAGE(PG8_SB(1, 1), b3 + hstepB, voffB); PG8_STAGE(PG8_SA(1, 0), a3, voffA);
            PG8_WAIT_V(8); PG8_WAIT_L(0); PG8_BAR; PG8_MMA(1, 0, At, B0); PG8_MMA(1, 1, At, B1); PG8_BAR; PG8_SCHED;
        }
        if constexpr (ALIGN_EPI) { if (wr == 0) PG8_BAR; }
        E(acc, cur, wr, wc, fr, fq); S.done(cur);
#if defined(MK_EPI2)
        if constexpr (Epi::IDEMP) { asm volatile("" ::: "memory"); E(acc, cur, wr, wc, fr, fq); }
#endif
        if (!has_next) break;
#pragma unroll
        for (int a = 0; a < 2; ++a)
#pragma unroll
            for (int b = 0; b < 2; ++b)
#pragma unroll
                for (int m = 0; m < 4; ++m)
#pragma unroll
                    for (int n = 0; n < 2; ++n) acc[a][b][m][n] = (f32x4){0.f, 0.f, 0.f, 0.f};
        cur = nxt; cA = nA; cB = nB; ++ui;
        if constexpr (ALIGN_EPI) { if (wr == 1) PG8_BAR; }
    }
    PG8_WAIT_V(0);
    if constexpr (!ALIGN_EPI) { if (wr == 0) PG8_BAR; }
    PG8_BAR;
#undef PG8_SA
#undef PG8_SB
#undef PG8_STAGE
#undef PG8_LDA
#undef PG8_LDB
#undef PG8_MMA
#undef PG8_WAIT_V
#undef PG8_WAIT_L
#undef PG8_BAR
#undef PG8_SCHED
}
}

namespace scan {
#define SLAS __attribute__((address_space(3)))
typedef short bf16x8 __attribute__((ext_vector_type(8)));
typedef float f32x16 __attribute__((ext_vector_type(16)));
typedef float f32x4 __attribute__((ext_vector_type(4)));
typedef unsigned u32x4 __attribute__((ext_vector_type(4)));
typedef unsigned u32x2 __attribute__((ext_vector_type(2)));
typedef __bf16 bf16x2v __attribute__((ext_vector_type(2)));
typedef float f32x2v __attribute__((ext_vector_type(2)));
#define MFMA32(a, b, c) __builtin_amdgcn_mfma_f32_32x32x16_bf16((a), (b), (c), 0, 0, 0)
__device__ __forceinline__ unsigned pk2c(float a, float b) { f32x2v f = {a, b}; bf16x2v r = __builtin_convertvector(f, bf16x2v); return __builtin_bit_cast(unsigned, r); }
__device__ __forceinline__ bf16x8 pack8(float a0, float a1, float a2, float a3, float a4, float a5, float a6, float a7) {
    u32x4 p; p.x = pk2c(a0, a1); p.y = pk2c(a2, a3); p.z = pk2c(a4, a5); p.w = pk2c(a6, a7); return __builtin_bit_cast(bf16x8, p); }
__device__ __forceinline__ int crow(int i, int hf) { return (i & 3) + 8 * (i >> 2) + 4 * hf; }
__device__ __forceinline__ float sigm(float x) { return __builtin_amdgcn_rcpf(1.f + __expf(-x)); }
__device__ __forceinline__ float gelu_t(float x) { const float u = 1.5957691216057308f * (x + 0.044715f * x * x * x); return x * sigm(u); }

constexpr int RG_NC = 32, RG_L = SEQ / RG_NC, RG_STEPS = RG_L / 16, RG_NS = NB * RG_NC;
constexpr int S5_NC = 256, S5_L = SEQ / S5_NC, S5_NS = NB * S5_NC, S5_UNITS = (S5_NS / 32) * NG;
constexpr size_t WS_RGP = WS_X1B, WS_RGS = WS_RGP + 512 * 1024, WS_RGH = WS_RGS + 512 * 1024;
constexpr size_t WS_S5S = WS_X1B + 2 * MiB, WS_S5H = WS_S5S + 16 * MiB;
static_assert(WS_S5H + 16 * MiB <= WS_Z, "scan scratch fits the X1B region");

constexpr float LOG2E = 1.4426950408889634f;
__device__ __forceinline__ void rglru_pack_weights(const float* __restrict__ wa, const float* __restrict__ wx, bf16_t* RGW, int idx) {
    const int lane = idx & 63, ks = (idx >> 6) & 7, gate = (idx >> 9) & 1, w4 = (idx >> 10) & 3, hd = idx >> 12;
    const float* p = (gate ? wx : wa) + (size_t)hd * HD * HD + (size_t)(16 * ks + 8 * (lane >> 5)) * HD + w4 * 32 + (lane & 31);
    ((bf16x8*)RGW)[idx] = pack8(-LOG2E * p[0], -LOG2E * p[HD], -LOG2E * p[2 * HD], -LOG2E * p[3 * HD], -LOG2E * p[4 * HD], -LOG2E * p[5 * HD], -LOG2E * p[6 * HD], -LOG2E * p[7 * HD]);
}
constexpr int RG_T_BYTES = 8704, RG_HB_LDS = 4 * RG_T_BYTES;
constexpr unsigned ROWB = DIN * 2;
#define RG_BARRIER() do { asm volatile("s_waitcnt lgkmcnt(0)" ::: "memory"); __builtin_amdgcn_s_barrier(); asm volatile("" ::: "memory"); } while (0)
template <bool PASS_B>
__device__ __forceinline__ void rglru_pass(SLAS unsigned char* lds, bf16_t* Z, const float* __restrict__ conv_w, const float* __restrict__ conv_b, const bf16_t* __restrict__ RGW, const float* __restrict__ ba,
                                           const float* __restrict__ bxp, const float* __restrict__ lam, float* RGP, float* RGS, const float* RGH, int bx, int G, int wave_s) {
    const int tid = fresh_tid(wave_s);
    const int lane = tid & 63, wave = wave_s, hb = wave >> 2, w4 = wave & 3;
    const int col = lane & 31, hf = lane >> 5;
    SLAS unsigned char* base = lds + hb * RG_HB_LDS;
#define RG_A(i) (base + (i) * RG_T_BYTES)
#define RG_G() (base + 2 * RG_T_BYTES)
#define RG_H() (base + 3 * RG_T_BYTES)
    const __amdgpu_buffer_rsrc_t zr = __builtin_amdgcn_make_buffer_rsrc(Z, 0, 0x7fffffff, 0x00020000);
    for (int ub = bx; ub < 256; ub += G) {
        const int unit = 2 * ub + hb, hd = unit & 15, sp = unit >> 4;
        const int cs = w4 >> 1, th = w4 & 1, cp = lane, s_conv = 2 * sp + cs, chc = hd * HD + 2 * cp;
        const int cconv = s_conv % RG_NC;
        const unsigned tok0 = (unsigned)((s_conv / RG_NC) * SEQ + cconv * RG_L);
        const unsigned vgc = (tok0 * DIN + O_GR + chc) * 2u;
        const unsigned vx3 = (tok0 * DIN + O_XR + chc) * 2u - (cconv > 0 ? 3u * ROWB : 0u);
        const int radj = cconv > 0 ? 0 : -3;
        const float2 cw0 = *(const float2*)(conv_w + 0 * D + chc), cw1 = *(const float2*)(conv_w + 1 * D + chc), cw2 = *(const float2*)(conv_w + 2 * D + chc), cw3 = *(const float2*)(conv_w + 3 * D + chc), cbv = *(const float2*)(conv_b + chc);
        const unsigned iooff = (unsigned)(4 * cs * 272 + 4 * cp);
        const int s_scan = 2 * sp + hf, ch = hd * HD + w4 * 32 + col;
        const float nba = -LOG2E * ba[ch], nbx = -LOG2E * bxp[ch], lac2 = -8.f * LOG2E * log1pf(expf(-lam[ch]));
        const unsigned scoff = (unsigned)(4 * hf * 272 + (w4 * 32 + col) * 2);
        bf16x8 Br[8], Bi[8];
        {
            const bf16x8* wf = (const bf16x8*)RGW + (size_t)((hd * 4 + w4) * 2) * 8 * 64 + lane;
#pragma unroll
            for (int ks = 0; ks < 8; ++ks) { Br[ks] = wf[ks * 64]; Bi[ks] = wf[(8 + ks) * 64]; }
        }
        float h = PASS_B ? RGH[(size_t)s_scan * D + ch] : 0.f, P = 1.f;
        unsigned X[11], GV[8];
        f32x16 accR, accI;
#define RG_TROW(k) (((k) & 3) + 8 * ((k) >> 2))
#define RG_LOADX(st) do { _Pragma("unroll") for (int j = 0; j < 11; ++j) { const int ridx = 16 * (st) + 8 * th + j + radj; \
            X[j] = (ridx >= 0) ? __builtin_amdgcn_raw_buffer_load_b32(zr, vx3, (unsigned)ridx * ROWB, 0) : 0u; } } while (0)
#define RG_LOADG(st) do { _Pragma("unroll") for (int j = 0; j < 8; ++j) GV[j] = __builtin_amdgcn_raw_buffer_load_b32(zr, vgc, (unsigned)(16 * (st) + 8 * th + j) * ROWB, 0); } while (0)
#define RG_CONV(st) do { SLAS unsigned char* At = RG_A((st) & 1) + iooff; float xl[11], xh[11]; \
            _Pragma("unroll") for (int j = 0; j < 11; ++j) { xl[j] = __uint_as_float(X[j] << 16); xh[j] = __uint_as_float(X[j] & 0xffff0000u); } \
            _Pragma("unroll") for (int j = 0; j < 8; ++j) { \
                const float c0 = fmaf(cw0.x, xl[j], fmaf(cw1.x, xl[j + 1], fmaf(cw2.x, xl[j + 2], fmaf(cw3.x, xl[j + 3], cbv.x)))); \
                const float c1 = fmaf(cw0.y, xh[j], fmaf(cw1.y, xh[j + 1], fmaf(cw2.y, xh[j + 2], fmaf(cw3.y, xh[j + 3], cbv.y)))); \
                *(SLAS unsigned*)(At + RG_TROW(8 * th + j) * 272) = pk2c(c0, c1); } } while (0)
#define RG_PUTG() do { SLAS unsigned char* Gt = RG_G() + iooff; _Pragma("unroll") for (int j = 0; j < 8; ++j) *(SLAS unsigned*)(Gt + RG_TROW(8 * th + j) * 272) = GV[j]; } while (0)
#define RG_COPYOUT(st) do { const SLAS unsigned char* Ht = RG_H() + iooff; _Pragma("unroll") for (int j = 0; j < 8; ++j) \
            __builtin_amdgcn_raw_buffer_store_b32(*(const SLAS unsigned*)(Ht + RG_TROW(8 * th + j) * 272), zr, vgc, (unsigned)(16 * (st) + 8 * th + j) * ROWB, 0); } while (0)
#define RG_MFMA(st) do { const SLAS unsigned char* At = RG_A((st) & 1); \
            _Pragma("unroll") for (int i = 0; i < 16; ++i) { accR[i] = nba; accI[i] = nbx; } \
            _Pragma("unroll") for (int ks = 0; ks < 8; ++ks) { const bf16x8 af = *(const SLAS bf16x8*)(At + col * 272 + (16 * ks + 8 * hf) * 2); accR = MFMA32(af, Br[ks], accR); accI = MFMA32(af, Bi[ks], accI); } } while (0)
#define RG_GATES(st) do { const SLAS unsigned char* Ax = RG_A((st) & 1) + scoff; const SLAS unsigned char* Gx = RG_G() + scoff; SLAS unsigned char* Hx = RG_H() + scoff; \
            _Pragma("unroll") for (int i = 0; i < 16; ++i) { \
                const float xc = bf2f(*(const SLAS bf16_t*)(Ax + RG_TROW(i) * 272)); \
                const float r = __builtin_amdgcn_rcpf(1.f + __builtin_amdgcn_exp2f(accR[i])), ig = __builtin_amdgcn_rcpf(1.f + __builtin_amdgcn_exp2f(accI[i])); \
                const float av = __builtin_amdgcn_exp2f(r * lac2); \
                const float mult = __builtin_amdgcn_sqrtf(fmaf(-av, av, 1.f)); \
                h = fmaf(av, h, (mult * ig) * xc); \
                if (PASS_B) { const float gv = bf2f(*(const SLAS bf16_t*)(Gx + RG_TROW(i) * 272)); *(SLAS bf16_t*)(Hx + RG_TROW(i) * 272) = (bf16_t)(pk2c(h * gv, 0.f) & 0xffffu); } \
                else P *= av; } } while (0)
        RG_LOADX(0); if (PASS_B) RG_LOADG(0);
        RG_CONV(0);
        RG_LOADX(1);
        RG_BARRIER();
        for (int p = 0; p < 2 * RG_STEPS + 2; ++p) {
            const int q = p - 1 - hb;
            if (q >= -1 && q <= 2 * RG_STEPS - 1) {
                if (q & 1) {
                    const int t = (q - 1) >> 1;
                    if (PASS_B && t >= 0) RG_COPYOUT(t);
                    if (t + 1 < RG_STEPS) RG_MFMA(t + 1);
                    if (t + 2 < RG_STEPS) RG_CONV(t + 2);
                    if (PASS_B && t + 1 < RG_STEPS) RG_PUTG();
                    if (t + 3 < RG_STEPS) RG_LOADX(t + 3);
                    if (PASS_B && t + 2 < RG_STEPS) RG_LOADG(t + 2);
                } else {
                    RG_GATES(q >> 1);
                }
            }
            RG_BARRIER();
        }
        if (!PASS_B) { RGP[(size_t)s_scan * D + ch] = P; RGS[(size_t)s_scan * D + ch] = h; }
#undef RG_TROW
#undef RG_LOADX
#undef RG_LOADG
#undef RG_CONV
#undef RG_PUTG
#undef RG_COPYOUT
#undef RG_MFMA
#undef RG_GATES
    }
#undef RG_A
#undef RG_G
#undef RG_H
}
__device__ __forceinline__ void rglru_carry(const float* RGP, const float* RGS, float* RGH, int idx) {
    const int b = idx / D, ch = idx % D; float H = 0.f;
#pragma unroll 8
    for (int c = 0; c < RG_NC; ++c) { const size_t o = (size_t)(b * RG_NC + c) * D + ch; RGH[o] = H; H = RGP[o] * H + RGS[o]; }
}

__device__ __forceinline__ size_t s5_idx(int g, int T, int row, int s) { return ((size_t)(g * 128 + (T >> 1) * 64 + (T & 1) * 32 + row)) * S5_NS + s; }
template <bool PASS_B>
__device__ __forceinline__ void s5_pass(bf16_t* Z, const float2* __restrict__ lamtab, const float* __restrict__ bbr, const float* __restrict__ bbi, const float* __restrict__ c_re, const float* __restrict__ c_im,
                                        const float* __restrict__ dd, float* S5S, const float* S5H, SLAS f32x2v* ltab  , int gw, int NGW, int lane) {
    const int col = lane & 31, hf = lane >> 5;
    for (int unit = gw; unit < S5_UNITS; unit += NGW) {
        const int g = unit & (NG - 1), sset = unit / NG;
        const int s = sset * 32 + col, b = s / S5_NC, c = s % S5_NC;
        bf16_t* zu = Z + ((size_t)b * SEQ + (size_t)c * S5_L) * DIN + O_U + g * GS;
        bf16x8 Ab[4];
#pragma unroll
        for (int T = 0; T < 4; ++T) { const float* src = ((T >> 1) ? bbi : bbr) + (size_t)(g * NP + 32 * (T & 1) + col) * GS + 8 * hf;
            Ab[T] = pack8(src[0], src[1], src[2], src[3], src[4], src[5], src[6], src[7]); }
        { const int e_hf = lane >> 5, e_tp = (lane >> 4) & 1, e_i = lane & 15; const float2 lv = lamtab[g * NP + 32 * e_tp + crow(e_i, e_hf)]; f32x2v lw = {lv.x, lv.y}; ltab[lane] = lw; }
        f32x16 h[4];
#pragma unroll
        for (int T = 0; T < 4; ++T)
#pragma unroll
            for (int i = 0; i < 16; ++i) h[T][i] = PASS_B ? S5H[s5_idx(g, T, crow(i, hf), s)] : 0.f;
        bf16x8 Ac[4][2], Adh, Adl;
        if (PASS_B) {
            const int hp = col & 15; const bool live = col < 16;
#pragma unroll
            for (int T = 0; T < 4; ++T)
#pragma unroll
                for (int sk = 0; sk < 2; ++sk) { float v[8];
#pragma unroll
                    for (int j = 0; j < 8; ++j) { const int p = 32 * (T & 1) + 16 * sk + 8 * (j >> 2) + 4 * hf + (j & 3);
                        const float cv = (T < 2) ? c_re[(size_t)(g * GS + hp) * NP + p] : -c_im[(size_t)(g * GS + hp) * NP + p]; v[j] = live ? cv : 0.f; }
                    Ac[T][sk] = pack8(v[0], v[1], v[2], v[3], v[4], v[5], v[6], v[7]); }
            const float dv = dd[g * GS + hp]; const float dhi = __uint_as_float(pk2c(dv, 0.f) << 16), dlo = dv - dhi;
            float vh[8], vl[8];
#pragma unroll
            for (int j = 0; j < 8; ++j) { const bool on = live && (hp == 8 * hf + j); vh[j] = on ? dhi : 0.f; vl[j] = on ? dlo : 0.f; }
            Adh = pack8(vh[0], vh[1], vh[2], vh[3], vh[4], vh[5], vh[6], vh[7]); Adl = pack8(vl[0], vl[1], vl[2], vl[3], vl[4], vl[5], vl[6], vl[7]);
        }
        bf16x8 u = *(const bf16x8*)(zu + 8 * hf);
        for (int step = 0; step < S5_L; ++step) {
            bf16x8 un = u;
            if (step + 1 < S5_L) un = *(const bf16x8*)(zu + (size_t)(step + 1) * DIN + 8 * hf);
            asm volatile("" ::: "memory");
#pragma unroll
            for (int tp = 0; tp < 2; ++tp) { f32x16 tr, ti;
#pragma unroll
                for (int i = 0; i < 16; i += 2) { const f32x4 l2 = *(const SLAS f32x4*)(ltab + (hf * 2 + tp) * 16 + i);
                    tr[i] = l2[0] * h[tp][i] - l2[1] * h[tp + 2][i]; ti[i] = l2[0] * h[tp + 2][i] + l2[1] * h[tp][i];
                    tr[i + 1] = l2[2] * h[tp][i + 1] - l2[3] * h[tp + 2][i + 1]; ti[i + 1] = l2[2] * h[tp + 2][i + 1] + l2[3] * h[tp][i + 1]; }
                h[tp] = MFMA32(Ab[tp], u, tr); h[tp + 2] = MFMA32(Ab[tp + 2], u, ti);
                __builtin_amdgcn_sched_barrier(0); }
            if (PASS_B) {
                f32x16 y;
#pragma unroll
                for (int i = 0; i < 16; ++i) y[i] = 0.f;
                y = MFMA32(Adh, u, y); y = MFMA32(Adl, u, y);
#pragma unroll
                for (int T = 0; T < 4; ++T)
#pragma unroll
                    for (int sk = 0; sk < 2; ++sk) { const bf16x8 xb = pack8(h[T][8 * sk], h[T][8 * sk + 1], h[T][8 * sk + 2], h[T][8 * sk + 3], h[T][8 * sk + 4], h[T][8 * sk + 5], h[T][8 * sk + 6], h[T][8 * sk + 7]);
                        y = MFMA32(Ac[T][sk], xb, y); }
                u32x2 o0, o1; o0.x = pk2c(gelu_t(y[0]), gelu_t(y[1])); o0.y = pk2c(gelu_t(y[2]), gelu_t(y[3])); o1.x = pk2c(gelu_t(y[4]), gelu_t(y[5])); o1.y = pk2c(gelu_t(y[6]), gelu_t(y[7]));
                bf16_t* zo = zu + (size_t)step * DIN + 4 * hf;
                *(u32x2*)zo = o0; *(u32x2*)(zo + 8) = o1;
            }
            u = un;
        }
        if (!PASS_B) {
#pragma unroll
            for (int T = 0; T < 4; ++T)
#pragma unroll
                for (int i = 0; i < 16; ++i) S5S[s5_idx(g, T, crow(i, hf), s)] = h[T][i];
        }
    }
}
__device__ __forceinline__ void s5_carry(const float2* __restrict__ lamtab, const float* S5S, float* S5H, int idx) {
    const int b = idx / (NG * NP), gp = idx % (NG * NP), g = gp / NP, p = gp % NP;
    float2 L = lamtab[gp];
#pragma unroll
    for (int k = 0; k < 5; ++k) { const float nr = L.x * L.x - L.y * L.y, ni = 2.f * L.x * L.y; L.x = nr; L.y = ni; }
    static_assert(S5_L == 32, "lambda^L by 5 squarings");
    const size_t ore = ((size_t)(g * 128 + p)) * S5_NS + (size_t)b * S5_NC, oim = ore + (size_t)64 * S5_NS;
    const f32x4* sre = (const f32x4*)(S5S + ore); const f32x4* sim = (const f32x4*)(S5S + oim);
    f32x4* hre = (f32x4*)(S5H + ore); f32x4* him = (f32x4*)(S5H + oim);
    float Hr = 0.f, Hi = 0.f;
#pragma unroll 4
    for (int c4 = 0; c4 < S5_NC / 4; ++c4) {
        const f32x4 vr = sre[c4], vi = sim[c4]; f32x4 orr, oi;
#pragma unroll
        for (int j = 0; j < 4; ++j) { orr[j] = Hr; oi[j] = Hi; const float nr = L.x * Hr - L.y * Hi + vr[j], ni = L.x * Hi + L.y * Hr + vi[j]; Hr = nr; Hi = ni; }
        hre[c4] = orr; him[c4] = oi;
    }
}
}

namespace cg = cooperative_groups;
#define LAS __attribute__((address_space(3)))
constexpr int NWAVES = 8, NTHREADS = NWAVES * 64;
constexpr int LDS_BYTES = 147456;
typedef float f32x4 __attribute__((ext_vector_type(4)));
typedef unsigned u32x4 __attribute__((ext_vector_type(4)));
typedef unsigned u32x2 __attribute__((ext_vector_type(2)));
struct Args { const float* in[N_IN]; float* out; unsigned char* ws; int ph_lo, ph_hi; };
static_assert(sizeof(Args) == (N_IN + 2) * 8 + 8, "Args has no padding");

__device__ __forceinline__ unsigned pk2(float lo, float hi) { return pg8::cvt_pk_bf16(lo, hi); }
__device__ __forceinline__ int rowmap(int mode, int n) { return mode == 0 ? n : ((n >> 7) * 256 + (mode == 2 ? 128 : 0) + (n & 127)); }
__device__ __forceinline__ void p0_transpose_item(const float* __restrict__ W, int K, int N, bf16_t* __restrict__ WT, int mode, LAS float* scr, int item, int lane) {
    const int nblk = N / 32, kb = item / nblk, nb = item % nblk, k0 = 64 * kb, n0 = 32 * nb;
#pragma unroll 8
    for (int i = 0; i < 32; ++i) { const int kk = 2 * i + (lane >> 5); scr[kk * 33 + (lane & 31)] = W[(size_t)(k0 + kk) * N + n0 + (lane & 31)]; }
    asm volatile("s_waitcnt lgkmcnt(0)" ::: "memory");
    const int c = lane & 7, rbase = rowmap(mode, n0);
#pragma unroll
    for (int j = 0; j < 4; ++j) { const int n = (lane >> 3) + 8 * j; const LAS float* s = scr + (8 * c) * 33 + n;
        u32x4 o; o.x = pk2(s[0 * 33], s[1 * 33]); o.y = pk2(s[2 * 33], s[3 * 33]); o.z = pk2(s[4 * 33], s[5 * 33]); o.w = pk2(s[6 * 33], s[7 * 33]);
        *(u32x4*)(WT + (size_t)(rbase + n) * K + k0 + 8 * c) = o; }
    asm volatile("s_waitcnt lgkmcnt(0)" ::: "memory");
}
__device__ __forceinline__ float wave_sum(float v) {
#pragma unroll
    for (int o = 1; o < 64; o <<= 1) v += __shfl_xor(v, o);
    return v;
}
__device__ __forceinline__ void ln_row(float* xrow, const float* __restrict__ g, const float* __restrict__ bt, bf16_t* orow, int lane) {
    f32x4* xr = (f32x4*)xrow + lane;
    f32x4 v[8]; float s = 0.f;
#pragma unroll
    for (int j = 0; j < 8; ++j) { v[j] = xr[64 * j]; s += (v[j].x + v[j].y) + (v[j].z + v[j].w); }
    const float mean = wave_sum(s) * (1.f / D); float s2 = 0.f;
#pragma unroll
    for (int j = 0; j < 8; ++j) { v[j] = v[j] - mean; s2 += (v[j].x * v[j].x + v[j].y * v[j].y) + (v[j].z * v[j].z + v[j].w * v[j].w); }
    const float rstd = rsqrtf(wave_sum(s2) * (1.f / D) + LN_EPS);
#pragma unroll
    for (int j = 0; j < 8; ++j) { const f32x4 gv = *((const f32x4*)g + lane + 64 * j), bv = *((const f32x4*)bt + lane + 64 * j);
        const f32x4 y = v[j] * rstd * gv + bv; xr[64 * j] = y;
        if (orow) { u32x2 w; w.x = pk2(y.x, y.y); w.y = pk2(y.z, y.w); *((u32x2*)orow + lane + 64 * j) = w; } }
}


#define XB_TMO      128
#define XB_XCNT(j)  (256  + 64 * (j))
#define XB_XSUB(j)  (1280 + 64 * (j))
#define XB_XGEN(j)  (2304 + 64 * (j))
#define XB_TOP      3328
#define XB_TOPGEN   3392
#define XCD_BAR_WORDS 3456
#define XB_SPIN_CAP (1u << 18)
__device__ __forceinline__ unsigned xb_ld(unsigned* p)              { return __hip_atomic_load(p, __ATOMIC_RELAXED, __HIP_MEMORY_SCOPE_AGENT); }
__device__ __forceinline__ unsigned xb_add(unsigned* p, unsigned v) { return __hip_atomic_fetch_add(p, v, __ATOMIC_RELAXED, __HIP_MEMORY_SCOPE_AGENT); }
__device__ __forceinline__ unsigned xb_xcc_id() { return (unsigned)__builtin_amdgcn_s_getreg((3 << 11) | 20) & 0xFu; }
#define XB_SPIN(cond, bar) do { unsigned _sp = 0; while (cond) { __builtin_amdgcn_s_sleep(1); \
    if ((++_sp & 255u) == 0u) { if (xb_ld(&(bar)[XB_TMO])) break; if (_sp > XB_SPIN_CAP) { atomicAdd(&(bar)[XB_TMO], 1u); break; } } } } while (0)
struct XcdBarrier { unsigned* bar; unsigned x; volatile LAS unsigned* st; };
__device__ __forceinline__ XcdBarrier xcd_barrier_post(unsigned* bar, volatile LAS unsigned* st, int wave_s) {
    XcdBarrier b; b.bar = bar; b.x = xb_xcc_id(); b.st = st;
    if (fresh_tid(wave_s) == 0) (void)xb_add(&bar[XB_XCNT(b.x)], 1u);
    return b;
}
__device__ __forceinline__ void xcd_barrier_complete(unsigned* bar, unsigned x, unsigned& nloc, unsigned& nx) {
    const unsigned G = gridDim.x * gridDim.y * gridDim.z;
    unsigned sum, cnt, mine, sp = 0u;
    for (;;) {
        sum = 0u; cnt = 0u; mine = 0u;
#pragma unroll
        for (unsigned j = 0; j < 16; ++j) { const unsigned c = xb_ld(&bar[XB_XCNT(j)]); sum += c; cnt += (c > 0u) ? 1u : 0u; mine = (j == x) ? c : mine; }
        if (sum == G) break;
        __builtin_amdgcn_s_sleep(1);
        if ((++sp & 255u) == 0u) { if (xb_ld(&bar[XB_TMO])) break; if (sp > XB_SPIN_CAP) { atomicAdd(&bar[XB_TMO], 1u); break; } }
    }
    nloc = mine > 0u ? mine : 1u; nx = cnt > 0u ? cnt : 1u;
}
__device__ __forceinline__ void xcd_barrier(const XcdBarrier& b, int wave_s) {
    asm volatile("s_waitcnt vmcnt(0)" ::: "memory");
    __syncthreads();
    if (fresh_tid(wave_s) == 0) {
        unsigned* bar = b.bar;
        __builtin_amdgcn_s_waitcnt(0);
        unsigned nloc = b.st[0], nx = b.st[1];
        if (nloc == 0u) { xcd_barrier_complete(bar, b.x, nloc, nx); b.st[0] = nloc; b.st[1] = nx; }
        const unsigned old = xb_add(&bar[XB_XSUB(b.x)], 1u);
        const unsigned gen = old / nloc;
        if (old + 1u == (gen + 1u) * nloc) {
            __builtin_amdgcn_fence(__ATOMIC_RELEASE, "agent");
            asm volatile("s_waitcnt vmcnt(0)" ::: "memory");
            const unsigned og = xb_add(&bar[XB_TOP], 1u);
            const unsigned tg = og / nx;
            if (og + 1u == (tg + 1u) * nx) xb_add(&bar[XB_TOPGEN], 1u);
            else XB_SPIN(xb_ld(&bar[XB_TOPGEN]) == tg, bar);
            __builtin_amdgcn_fence(__ATOMIC_ACQUIRE, "agent");
            xb_add(&bar[XB_XGEN(b.x)], 1u);
            asm volatile("s_waitcnt vmcnt(0)" ::: "memory");
        } else {
            XB_SPIN(xb_ld(&bar[XB_XGEN(b.x)]) == gen, bar);
            __builtin_amdgcn_fence(__ATOMIC_ACQUIRE, "agent");
            asm volatile("s_waitcnt vmcnt(0)" ::: "memory");
        }
    }
    __syncthreads();
}

__global__ void __launch_bounds__(NTHREADS, 2) mk_fwd(Args a) {
    extern __shared__ __attribute__((aligned(16))) unsigned char lds_raw[];
    LAS unsigned char* lds = (LAS unsigned char*)lds_raw;
    cg::grid_group grid = cg::this_grid();
    const int wave_s = __builtin_amdgcn_readfirstlane(threadIdx.x >> 6);
#define FRESH_IDS() const int tid = fresh_tid(wave_s), lane = tid & 63, wave = wave_s, gw = bx * NWAVES + wave; (void)lane; (void)gw
    const int G = gridDim.x, bx = blockIdx.x;
    const int NGW = G * NWAVES;
    unsigned char* ws = a.ws;
    bf16_t *Wt_in = (bf16_t*)(ws + WS_WIN), *Wt_a = (bf16_t*)(ws + WS_WA), *Wt_glu = (bf16_t*)(ws + WS_WGLU), *Wt_out = (bf16_t*)(ws + WS_WOUT), *Wt_up = (bf16_t*)(ws + WS_WUP), *Wt_down = (bf16_t*)(ws + WS_WDOWN);
    bf16_t *X1B = (bf16_t*)(ws + WS_X1B), *Z = (bf16_t*)(ws + WS_Z), *HMID = (bf16_t*)(ws + WS_Z), *XB = (bf16_t*)a.out;
    const int lo = a.ph_lo, hi = a.ph_hi;
#ifndef MK_DUP
#define MK_DUP 0
#endif
#define DUP(k) (((MK_DUP >> (k)) & 1) != 0)
#define IN(k) (lo <= (k) && (k) < hi)
    volatile LAS unsigned* MISC = (volatile LAS unsigned*)(lds + LDS_BYTES - 64);
    { const int t0 = fresh_tid(wave_s); if (t0 < 16) MISC[t0] = 0u; }
    __syncthreads();
    XcdBarrier xbar = xcd_barrier_post((unsigned*)(ws + WS_CTL), MISC, wave_s);
#ifndef MK_CG_SEAMS
#define MK_CG_SEAMS 0
#endif
#define SEAM(k) do { if (IN(k) && IN((k) + 1)) { if ((k) < MK_CG_SEAMS) grid.sync(); else xcd_barrier(xbar, wave_s); } } while (0)

    if (IN(0)) {
        FRESH_IDS();
        LAS float* scr = (LAS float*)(lds + wave * 16384);
        constexpr int I_IN = (D / 64) * (DIN / 32), I_A = (D / 64) * (D / 32), I_GL = (DSSM / 64) * (D / 32), I_UP = (D / 64) * (DFF / 32), I_DN = (DFF / 64) * (D / 32);
        constexpr int NITEMS = I_IN + 2 * I_A + 2 * I_GL + I_UP + I_DN;
        for (int it = gw; it < NITEMS; it += NGW) {
            int r = it;
            if (r < I_IN) { p0_transpose_item(a.in[I_WIN], D, DIN, Wt_in, 0, scr, r, lane); continue; } r -= I_IN;
            if (r < I_A) { p0_transpose_item(a.in[I_WAOUT], D, D, Wt_a, 0, scr, r, lane); continue; } r -= I_A;
            if (r < I_GL) { p0_transpose_item(a.in[I_GLUW], DSSM, D, Wt_glu, 1, scr, r, lane); continue; } r -= I_GL;
            if (r < I_GL) { p0_transpose_item(a.in[I_GLUV], DSSM, D, Wt_glu, 2, scr, r, lane); continue; } r -= I_GL;
            if (r < I_A) { p0_transpose_item(a.in[I_WOUT], D, D, Wt_out, 0, scr, r, lane); continue; } r -= I_A;
            if (r < I_UP) { p0_transpose_item(a.in[I_WUP], D, DFF, Wt_up, 0, scr, r, lane); continue; } r -= I_UP;
            p0_transpose_item(a.in[I_WDOWN], DFF, D, Wt_down, 0, scr, r, lane);
        }
        {
            const float* x = a.in[I_X]; const size_t n8 = (size_t)M * D / 8;
            for (size_t i = (size_t)bx * NTHREADS + tid; i < n8; i += (size_t)G * NTHREADS) {
                const f32x4 v0 = *((const f32x4*)x + 2 * i), v1 = *((const f32x4*)x + 2 * i + 1);
                u32x4 w; w.x = pk2(v0.x, v0.y); w.y = pk2(v0.z, v0.w); w.z = pk2(v1.x, v1.y); w.w = pk2(v1.z, v1.w);
                *((u32x4*)XB + i) = w; }
        }
        for (int idx = bx * NTHREADS + tid; idx < 16 * 4 * 2 * 8 * 64; idx += G * NTHREADS) scan::rglru_pack_weights(a.in[I_WA], a.in[I_WX], (bf16_t*)(ws + WS_RGW), idx);
        {
            const int idx = bx * NTHREADS + tid;
            if (idx < NG * NP) {
                float2* lam = (float2*)(ws + WS_S5LAM); float* bbr = (float*)(ws + WS_S5BBR); float* bbi = (float*)(ws + WS_S5BBI);
                const int g = idx / NP;
                const double dt = exp((double)a.in[I_LOGDT][g]);
                const double lr = fmin((double)a.in[I_ARE][idx], -1e-4), li = (double)a.in[I_AIM][idx];
                const double mag = exp(lr * dt), lbr = mag * cos(li * dt), lbi = mag * sin(li * dt);
                const double zr = lbr - 1.0, zi = lbi, den = lr * lr + li * li;
                const double fr = (zr * lr + zi * li) / den, fi = (zi * lr - zr * li) / den;
                lam[idx] = make_float2((float)lbr, (float)lbi);
                for (int h = 0; h < GS; ++h) { const double br = a.in[I_BRE][idx * GS + h], bi = a.in[I_BIM][idx * GS + h];
                    bbr[idx * GS + h] = (float)(fr * br - fi * bi); bbi[idx * GS + h] = (float)(fr * bi + fi * br); }
            }
        }
        __syncthreads();
    }
    SEAM(0);
    if (IN(1)) { pg8::Gemm g{XB, D, Wt_in, D, M, DIN, D}; pg8::StaticOrder S; S.init(M, DIN, G, bx); pg8::gemm_phase(lds, g, S, pg8::EpiZ{Z}, wave_s); if (DUP(1)) pg8::gemm_phase(lds, g, S, pg8::EpiZ{Z}, wave_s); }
    SEAM(1);
    {
        const float2* lamtab = (const float2*)(ws + WS_S5LAM); const float* bbr = (const float*)(ws + WS_S5BBR); const float* bbi = (const float*)(ws + WS_S5BBI);
        const bf16_t* RGW = (const bf16_t*)(ws + WS_RGW); float *RGP = (float*)(ws + scan::WS_RGP), *RGS = (float*)(ws + scan::WS_RGS), *RGH = (float*)(ws + scan::WS_RGH), *S5S = (float*)(ws + scan::WS_S5S), *S5H = (float*)(ws + scan::WS_S5H);
        if (IN(2)) {
            FRESH_IDS();
            scan::rglru_pass<false>(lds, Z, a.in[I_CONVW], a.in[I_CONVB], RGW, a.in[I_BA], a.in[I_BX], a.in[I_LAM], RGP, RGS, RGH, bx, G, wave_s);
            scan::s5_pass<false>(Z, lamtab, bbr, bbi, a.in[I_CRE], a.in[I_CIM], a.in[I_SD], S5S, S5H, (LAS scan::f32x2v*)(lds + 2 * scan::RG_HB_LDS + wave * 512), gw, NGW, lane);
            if (DUP(2)) { __syncthreads(); scan::rglru_pass<false>(lds, Z, a.in[I_CONVW], a.in[I_CONVB], RGW, a.in[I_BA], a.in[I_BX], a.in[I_LAM], RGP, RGS, RGH, bx, G, wave_s); }
            if (DUP(12)) { scan::s5_pass<false>(Z, lamtab, bbr, bbi, a.in[I_CRE], a.in[I_CIM], a.in[I_SD], S5S, S5H, (LAS scan::f32x2v*)(lds + 2 * scan::RG_HB_LDS + wave * 512), gw, NGW, lane); }
        }
        SEAM(2);
        if (IN(3)) {
            FRESH_IDS();
            if (tid < 48) for (int idx = bx * 48 + tid; idx < NB * NG * NP + NB * D; idx += G * 48) {
                if (idx < NB * NG * NP) scan::s5_carry(lamtab, S5S, S5H, idx); else scan::rglru_carry(RGP, RGS, RGH, idx - NB * NG * NP); }
            if (DUP(3)) { if (tid < 48) for (int idx = bx * 48 + tid; idx < NB * NG * NP + NB * D; idx += G * 48) {
                if (idx < NB * NG * NP) scan::s5_carry(lamtab, S5S, S5H, idx); else scan::rglru_carry(RGP, RGS, RGH, idx - NB * NG * NP); } }
        }
        SEAM(3);
        if (IN(4)) {
            FRESH_IDS();
            scan::rglru_pass<true>(lds, Z, a.in[I_CONVW], a.in[I_CONVB], RGW, a.in[I_BA], a.in[I_BX], a.in[I_LAM], RGP, RGS, RGH, bx, G, wave_s);
            scan::s5_pass<true>(Z, lamtab, bbr, bbi, a.in[I_CRE], a.in[I_CIM], a.in[I_SD], S5S, S5H, (LAS scan::f32x2v*)(lds + 2 * scan::RG_HB_LDS + wave * 512), gw, NGW, lane);
        }
        SEAM(4);
    }
    if (IN(5)) { pg8::Gemm g{Z + O_U, DIN, Wt_glu, DSSM, M, 2 * D, DSSM}; pg8::StaticOrder S; S.init(M, 2 * D, G, bx); pg8::gemm_phase(lds, g, S, pg8::EpiGlu{Z}, wave_s); }
    SEAM(5);
    if (IN(6)) { pg8::Gemm g{Z + O_GR, DIN, Wt_a, D, M, D, D}; pg8::StaticOrder S; S.init(M, D, G, bx); pg8::gemm_phase(lds, g, S, pg8::EpiMix{Z}, wave_s); }
    SEAM(6);
    if (IN(7)) { pg8::Gemm g{Z + O_GA, DIN, Wt_out, D, M, D, D}; pg8::StaticOrder S; S.init(M, D, G, bx); pg8::gemm_phase(lds, g, S, pg8::EpiR1{a.in[I_X], a.out}, wave_s); if (DUP(7)) pg8::gemm_phase(lds, g, S, pg8::EpiR1{a.in[I_X], a.out}, wave_s); }
    SEAM(7);
    if (IN(8)) { FRESH_IDS(); for (int m = gw; m < M; m += NGW) ln_row(a.out + (size_t)m * D, a.in[I_LN1G], a.in[I_LN1B], X1B + (size_t)m * D, lane); }
    SEAM(8);
    if (IN(9)) { pg8::Gemm g{X1B, D, Wt_up, D, M, DFF, D}; pg8::StaticOrder S; S.init(M, DFF, G, bx); pg8::gemm_phase(lds, g, S, pg8::EpiUp{HMID, a.in[I_BUP]}, wave_s); if (DUP(9)) pg8::gemm_phase(lds, g, S, pg8::EpiUp{HMID, a.in[I_BUP]}, wave_s); }
    SEAM(9);
    if (IN(10)) { pg8::Gemm g{HMID, DFF, Wt_down, DFF, M, D, DFF}; pg8::StaticOrder S; S.init(M, D, G, bx); pg8::gemm_phase(lds, g, S, pg8::EpiR2{a.out, a.in[I_BDOWN]}, wave_s); }
    SEAM(10);
    if (IN(11)) { FRESH_IDS(); for (int m = gw; m < M; m += NGW) ln_row(a.out + (size_t)m * D, a.in[I_LN2G], a.in[I_LN2B], nullptr, lane); }
#undef IN
#undef SEAM
}

#ifndef MK_SCAN_NAIVE
#define MK_SCAN_NAIVE 0
#endif
static hipError_t launch_mk(Args& a, int lo, int hi, int grid, hipStream_t stream) {
    a.ph_lo = lo; a.ph_hi = hi; void* args[] = {&a};
    return hipLaunchCooperativeKernel((const void*)mk_fwd, dim3(grid), dim3(NTHREADS), args, LDS_BYTES, stream);
}
extern "C" void kernel_launch(void* const* d_in, const int* in_sizes, int n_in, void* d_out, int out_size, void* d_ws, size_t ws_size, hipStream_t stream) {
    static int grid = 0;
    if (grid == 0) {
        if (n_in != N_IN || out_size != M * D || ws_size < WS_END) { fprintf(stderr, "kernel_launch: unexpected shapes (n_in %d out %d ws %zu)\n", n_in, out_size, ws_size); grid = -1; return; }
        int dev = 0, cus = 0, per_cu = 0;
        if (hipGetDevice(&dev) != hipSuccess || hipDeviceGetAttribute(&cus, hipDeviceAttributeMultiprocessorCount, dev) != hipSuccess) { grid = -1; return; }
        if (hipFuncSetAttribute((const void*)mk_fwd, hipFuncAttributeMaxDynamicSharedMemorySize, LDS_BYTES) != hipSuccess) { fprintf(stderr, "kernel_launch: hipFuncSetAttribute failed\n"); grid = -1; return; }
        if (hipOccupancyMaxActiveBlocksPerMultiprocessor(&per_cu, (const void*)mk_fwd, NTHREADS, LDS_BYTES) != hipSuccess || per_cu < 1) { fprintf(stderr, "kernel_launch: occupancy query says %d\n", per_cu); grid = -1; return; }
        grid = cus;
#if MK_SCAN_NAIVE
        (void)hipFuncSetAttribute((const void*)nv::k_rglru, hipFuncAttributeMaxDynamicSharedMemorySize, (2 * HD * HD + HD) * 4);
#endif
    }
    if (grid < 0) return;
    Args a{};
    for (int i = 0; i < N_IN; ++i) a.in[i] = (const float*)d_in[i];
    a.out = (float*)d_out; a.ws = (unsigned char*)d_ws;
    hipError_t e;
    if (hipMemsetAsync((char*)d_ws + WS_CTL, 0, 16384, stream) != hipSuccess) { fprintf(stderr, "kernel_launch: memset of the barrier words failed\n"); return; }
#if MK_SCAN_NAIVE
    unsigned char* ws = (unsigned char*)d_ws; bf16_t* Z = (bf16_t*)(ws + WS_Z);
    e = launch_mk(a, 0, 2, grid, stream);
    nv::k_rglru<<<NB * HEADS, 128, (2 * HD * HD + HD) * 4, stream>>>(Z, a.in[I_CONVW], a.in[I_CONVB], a.in[I_WA], a.in[I_BA], a.in[I_WX], a.in[I_BX], a.in[I_LAM]);
    nv::k_s5<<<NB * NG, 64, 0, stream>>>(Z, (const float2*)(ws + WS_S5LAM), (const float*)(ws + WS_S5BBR), (const float*)(ws + WS_S5BBI), a.in[I_CRE], a.in[I_CIM], a.in[I_SD]);
    if (e == hipSuccess) e = launch_mk(a, 5, 12, grid, stream);
#else
    e = launch_mk(a, 0, 12, grid, stream);
#endif
    if (e != hipSuccess) fprintf(stderr, "kernel_launch: cooperative launch failed: %s (grid %d)\n", hipGetErrorString(e), grid);
}
```

```cpp
#include <hip/hip_runtime.h>
#include <hip/hip_cooperative_groups.h>
#include <cstdio>
#include <cstdint>

typedef unsigned short bf16_t;
constexpr int NB = 2, SEQ = 8192, M = NB * SEQ, D = 2048, HEADS = 16, HD = 128, DSSM = 1024, NG = 64, GS = 16, NP = 64, DFF = 8192, DIN = 9216;
constexpr int O_XR = 0, O_GR = 2048, O_U = 4096, O_GA = 5120, O_GB = 7168;
constexpr float ALPHA = 1.189207115002721f;
constexpr float LN_EPS = 1e-5f;
enum { I_X = 0, I_WIN, I_CONVW, I_CONVB, I_WA, I_BA, I_WX, I_BX, I_LAM, I_WAOUT, I_ARE, I_AIM, I_LOGDT, I_BRE, I_BIM, I_CRE, I_CIM, I_SD, I_GLUW, I_GLUV, I_WOUT,
       I_LN1G, I_LN1B, I_WUP, I_BUP, I_WDOWN, I_BDOWN, I_LN2G, I_LN2B, N_IN };

constexpr size_t MiB = 1u << 20;
constexpr size_t WS_CTL = 0;
constexpr size_t WS_S5LAM = 1 * MiB;
constexpr size_t WS_S5BBR = WS_S5LAM + 64 * 1024;
constexpr size_t WS_S5BBI = WS_S5BBR + 256 * 1024;
constexpr size_t WS_WIN = 2 * MiB;
constexpr size_t WS_WA = WS_WIN + 36 * MiB;
constexpr size_t WS_WGLU = WS_WA + 8 * MiB;
constexpr size_t WS_WOUT = WS_WGLU + 8 * MiB;
constexpr size_t WS_WUP = WS_WOUT + 8 * MiB;
constexpr size_t WS_WDOWN = WS_WUP + 32 * MiB;
constexpr size_t WS_X1B = WS_WDOWN + 32 * MiB;
constexpr size_t WS_Z = WS_X1B + 64 * MiB;
constexpr size_t WS_RGW = WS_Z + 288 * MiB;
constexpr size_t WS_END = WS_RGW + 1 * MiB;

__device__ __forceinline__ bf16_t f2bf(float f) { unsigned u = __float_as_uint(f); u += 0x7fffu + ((u >> 16) & 1u); return (bf16_t)(u >> 16); }
__device__ __forceinline__ float bf2f(bf16_t b) { return __uint_as_float(((unsigned)b) << 16); }
__device__ __forceinline__ float sigmoid_f(float x) { return 1.f / (1.f + __expf(-x)); }
__device__ __forceinline__ float gelu_tanh(float x) { const float u = 1.5957691216057308f * (x + 0.044715f * x * x * x); return x * sigmoid_f(u); }

namespace nv {
__device__ __forceinline__ int rowmap(int mode, int n) { return mode == 0 ? n : ((n >> 7) * 256 + (mode == 2 ? 128 : 0) + (n & 127)); }
__global__ void k_transpose(const float* __restrict__ W, int K, int N, bf16_t* __restrict__ Wt, int mode) {
    __shared__ float tile[32][33];
    const int n0 = blockIdx.x * 32, k0 = blockIdx.y * 32;
    for (int i = threadIdx.y; i < 32; i += 8) tile[i][threadIdx.x] = W[(size_t)(k0 + i) * N + n0 + threadIdx.x];
    __syncthreads();
    for (int i = threadIdx.y; i < 32; i += 8) { const int row = rowmap(mode, n0 + i); Wt[(size_t)row * K + k0 + threadIdx.x] = f2bf(tile[threadIdx.x][i]); }
}
__global__ void k_cvt(const float* __restrict__ x, bf16_t* __restrict__ xb, size_t n) {
    for (size_t i = (size_t)blockIdx.x * blockDim.x + threadIdx.x; i < n; i += (size_t)gridDim.x * blockDim.x) xb[i] = f2bf(x[i]);
}
__global__ void k_s5_params(const float* a_re, const float* a_im, const float* log_dt, const float* b_re, const float* b_im, float2* lam, float* bbr, float* bbi) {
    const int idx = blockIdx.x * blockDim.x + threadIdx.x; if (idx >= NG * NP) return;
    const int g = idx / NP;
    const double dt = exp((double)log_dt[g]);
    const double lr = fmin((double)a_re[idx], -1e-4), li = (double)a_im[idx];
    const double mag = exp(lr * dt), lbr = mag * cos(li * dt), lbi = mag * sin(li * dt);
    const double zr = lbr - 1.0, zi = lbi, den = lr * lr + li * li;
    const double fr = (zr * lr + zi * li) / den, fi = (zi * lr - zr * li) / den;
    lam[idx] = make_float2((float)lbr, (float)lbi);
    for (int h = 0; h < GS; ++h) { const double br = b_re[idx * GS + h], bi = b_im[idx * GS + h];
        bbr[idx * GS + h] = (float)(fr * br - fi * bi); bbi[idx * GS + h] = (float)(fr * bi + fi * br); }
}
template <class Epi> __global__ void __launch_bounds__(256) k_gemm(const bf16_t* __restrict__ A, int lda, const bf16_t* __restrict__ Bt, int ldb, int K, Epi E) {
    __shared__ float As[16][68], Bs[16][68];
    const int tid = threadIdx.x, tx = tid & 15, ty = tid >> 4, m0 = blockIdx.y * 64, n0 = blockIdx.x * 64;
    float acc[4][4];
#pragma unroll
    for (int i = 0; i < 4; ++i)
#pragma unroll
        for (int j = 0; j < 4; ++j) acc[i][j] = 0.f;
    const int lr = tid >> 2, lk = (tid & 3) * 4;
    for (int k0 = 0; k0 < K; k0 += 16) {
        const ushort4 av = *(const ushort4*)(A + (size_t)(m0 + lr) * lda + k0 + lk);
        const ushort4 bv = *(const ushort4*)(Bt + (size_t)(n0 + lr) * ldb + k0 + lk);
        As[lk + 0][lr] = bf2f(av.x); As[lk + 1][lr] = bf2f(av.y); As[lk + 2][lr] = bf2f(av.z); As[lk + 3][lr] = bf2f(av.w);
        Bs[lk + 0][lr] = bf2f(bv.x); Bs[lk + 1][lr] = bf2f(bv.y); Bs[lk + 2][lr] = bf2f(bv.z); Bs[lk + 3][lr] = bf2f(bv.w);
        __syncthreads();
#pragma unroll
        for (int k = 0; k < 16; ++k) {
            const float4 a = *(const float4*)&As[k][ty * 4], b = *(const float4*)&Bs[k][tx * 4];
            const float aa[4] = {a.x, a.y, a.z, a.w}, bb[4] = {b.x, b.y, b.z, b.w};
#pragma unroll
            for (int i = 0; i < 4; ++i)
#pragma unroll
                for (int j = 0; j < 4; ++j) acc[i][j] += aa[i] * bb[j];
        }
        __syncthreads();
    }
#pragma unroll
    for (int i = 0; i < 4; ++i)
#pragma unroll
        for (int j = 0; j < 4; ++j) E(m0 + ty * 4 + i, n0 + tx * 4 + j, acc[i][j]);
}
__global__ void __launch_bounds__(256) k_glu(const bf16_t* __restrict__ A, int lda, const bf16_t* __restrict__ Bt, int K, bf16_t* Z) {
    __shared__ float As[16][68], Bw[16][68], Bv[16][68];
    const int tid = threadIdx.x, tx = tid & 15, ty = tid >> 4, m0 = blockIdx.y * 64, n0 = blockIdx.x * 64;
    float aw[4][4], avv[4][4];
#pragma unroll
    for (int i = 0; i < 4; ++i)
#pragma unroll
        for (int j = 0; j < 4; ++j) { aw[i][j] = 0.f; avv[i][j] = 0.f; }
    const int lr = tid >> 2, lk = (tid & 3) * 4;
    const int rw = rowmap(1, n0 + lr), rv = rowmap(2, n0 + lr);
    for (int k0 = 0; k0 < K; k0 += 16) {
        const ushort4 a4 = *(const ushort4*)(A + (size_t)(m0 + lr) * lda + k0 + lk);
        const ushort4 w4 = *(const ushort4*)(Bt + (size_t)rw * K + k0 + lk);
        const ushort4 v4 = *(const ushort4*)(Bt + (size_t)rv * K + k0 + lk);
        As[lk + 0][lr] = bf2f(a4.x); As[lk + 1][lr] = bf2f(a4.y); As[lk + 2][lr] = bf2f(a4.z); As[lk + 3][lr] = bf2f(a4.w);
        Bw[lk + 0][lr] = bf2f(w4.x); Bw[lk + 1][lr] = bf2f(w4.y); Bw[lk + 2][lr] = bf2f(w4.z); Bw[lk + 3][lr] = bf2f(w4.w);
        Bv[lk + 0][lr] = bf2f(v4.x); Bv[lk + 1][lr] = bf2f(v4.y); Bv[lk + 2][lr] = bf2f(v4.z); Bv[lk + 3][lr] = bf2f(v4.w);
        __syncthreads();
#pragma unroll
        for (int k = 0; k < 16; ++k) {
            const float4 a = *(const float4*)&As[k][ty * 4], w = *(const float4*)&Bw[k][tx * 4], v = *(const float4*)&Bv[k][tx * 4];
            const float aa[4] = {a.x, a.y, a.z, a.w}, ww[4] = {w.x, w.y, w.z, w.w}, vv[4] = {v.x, v.y, v.z, v.w};
#pragma unroll
            for (int i = 0; i < 4; ++i)
#pragma unroll
                for (int j = 0; j < 4; ++j) { aw[i][j] += aa[i] * ww[j]; avv[i][j] += aa[i] * vv[j]; }
        }
        __syncthreads();
    }
#pragma unroll
    for (int i = 0; i < 4; ++i)
#pragma unroll
        for (int j = 0; j < 4; ++j) { const int row = m0 + ty * 4 + i, col = n0 + tx * 4 + j; bf16_t* p = Z + (size_t)row * DIN + O_GB + col;
            *p = f2bf(aw[i][j] * sigmoid_f(avv[i][j]) * bf2f(*p)); }
}
__global__ void __launch_bounds__(128) k_rglru(bf16_t* Z, const float* conv_w, const float* conv_b, const float* wa, const float* ba, const float* wx, const float* bx, const float* lam) {
    extern __shared__ float sm[];
    float* s_wa = sm; float* s_wx = sm + HD * HD; float* s_xc = sm + 2 * HD * HD;
    const int b = blockIdx.x / HEADS, hd = blockIdx.x % HEADS, j = threadIdx.x, ch = hd * HD + j;
    for (int i = j; i < HD * HD; i += 128) { s_wa[i] = wa[(size_t)hd * HD * HD + i]; s_wx[i] = wx[(size_t)hd * HD * HD + i]; }
    const float cw0 = conv_w[0 * D + ch], cw1 = conv_w[1 * D + ch], cw2 = conv_w[2 * D + ch], cw3 = conv_w[3 * D + ch], cb = conv_b[ch];
    const float bav = ba[ch], bxv = bx[ch];
    const float lac = -8.f * log1pf(expf(-lam[ch]));
    float x1 = 0.f, x2 = 0.f, x3 = 0.f, h = 0.f;
    __syncthreads();
    bf16_t* zr = Z + (size_t)b * SEQ * DIN;
    for (int t = 0; t < SEQ; ++t) {
        const float x0 = bf2f(zr[(size_t)t * DIN + O_XR + ch]);
        const float xc = cw0 * x3 + cw1 * x2 + cw2 * x1 + cw3 * x0 + cb;
        x3 = x2; x2 = x1; x1 = x0;
        s_xc[j] = xc;
        __syncthreads();
        float rp = bav, ip = bxv;
#pragma unroll 8
        for (int i = 0; i < HD; ++i) { const float v = s_xc[i]; rp += v * s_wa[i * HD + j]; ip += v * s_wx[i * HD + j]; }
        __syncthreads();
        const float r = sigmoid_f(rp), ig = sigmoid_f(ip);
        const float la = r * lac, a = expf(la), mult = sqrtf(-expm1f(2.f * la));
        h = a * h + mult * (ig * xc);
        bf16_t* g = zr + (size_t)t * DIN + O_GR + ch;
        *g = f2bf(h * bf2f(*g));
    }
}
__global__ void __launch_bounds__(64) k_s5(bf16_t* Z, const float2* lamb, const float* bbr, const float* bbi, const float* c_re, const float* c_im, const float* dd) {
    const int b = blockIdx.x / NG, g = blockIdx.x % NG, p = threadIdx.x;
    float br[GS], bi[GS], cr[GS], ci[GS];
#pragma unroll
    for (int h = 0; h < GS; ++h) { br[h] = bbr[(g * NP + p) * GS + h]; bi[h] = bbi[(g * NP + p) * GS + h]; cr[h] = c_re[(g * GS + h) * NP + p]; ci[h] = c_im[(g * GS + h) * NP + p]; }
    const float2 l = lamb[g * NP + p];
    const float dv = dd[g * GS + (p & 15)];
    float hr = 0.f, hi = 0.f;
    bf16_t* zr = Z + (size_t)b * SEQ * DIN + O_U + g * GS;
    for (int t = 0; t < SEQ; ++t) {
        const float ul = bf2f(zr[(size_t)t * DIN + (p & 15)]);
        float bur = 0.f, bui = 0.f;
#pragma unroll
        for (int h = 0; h < GS; ++h) { const float u = __shfl(ul, h); bur += br[h] * u; bui += bi[h] * u; }
        const float nr = l.x * hr - l.y * hi + bur, ni = l.x * hi + l.y * hr + bui; hr = nr; hi = ni;
        float yv = 0.f;
#pragma unroll
        for (int h = 0; h < GS; ++h) { float v = cr[h] * hr - ci[h] * hi;
#pragma unroll
            for (int o = 1; o < 64; o <<= 1) v += __shfl_xor(v, o);
            yv = (p == h) ? v : yv; }
        if (p < GS) zr[(size_t)t * DIN + p] = f2bf(gelu_tanh(yv + dv * ul));
    }
}
__global__ void __launch_bounds__(256) k_ln(float* X, const float* g, const float* bt, bf16_t* xb) {
    __shared__ float red[8];
    const int row = blockIdx.x, tid = threadIdx.x; float* xr = X + (size_t)row * D;
    float v[8]; float s = 0.f;
#pragma unroll
    for (int i = 0; i < 8; ++i) { v[i] = xr[tid + 256 * i]; s += v[i]; }
#pragma unroll
    for (int o = 1; o < 64; o <<= 1) s += __shfl_xor(s, o);
    if ((tid & 63) == 0) red[tid >> 6] = s;
    __syncthreads();
    const float mean = (red[0] + red[1] + red[2] + red[3]) * (1.f / D);
    float q = 0.f;
#pragma unroll
    for (int i = 0; i < 8; ++i) { v[i] -= mean; q += v[i] * v[i]; }
#pragma unroll
    for (int o = 1; o < 64; o <<= 1) q += __shfl_xor(q, o);
    if ((tid & 63) == 0) red[4 + (tid >> 6)] = q;
    __syncthreads();
    const float rstd = rsqrtf((red[4] + red[5] + red[6] + red[7]) * (1.f / D) + LN_EPS);
#pragma unroll
    for (int i = 0; i < 8; ++i) { const int c = tid + 256 * i; const float y = v[i] * rstd * g[c] + bt[c]; xr[c] = y; if (xb) xb[(size_t)row * D + c] = f2bf(y); }
}
struct EpiZ { bf16_t* Z; __device__ void operator()(int r, int c, float a) const {
    float v = a; if (c >= O_GR && c < O_U) v = gelu_tanh(a); else if (c >= O_GA) v = sigmoid_f(a); Z[(size_t)r * DIN + c] = f2bf(v); } };
struct EpiMix { bf16_t* Z; __device__ void operator()(int r, int c, float a) const {
    bf16_t* p = Z + (size_t)r * DIN + O_GA + c; *p = f2bf(bf2f(*p) * a + bf2f(Z[(size_t)r * DIN + O_GB + c])); } };
struct EpiR1 { const float* x; float* out; __device__ void operator()(int r, int c, float a) const { out[(size_t)r * D + c] = ALPHA * x[(size_t)r * D + c] + a; } };
struct EpiUp { bf16_t* H; const float* b; __device__ void operator()(int r, int c, float a) const { const float v = fmaxf(a + b[c], 0.f); H[(size_t)r * DFF + c] = f2bf(v * v); } };
struct EpiR2 { float* out; const float* b; __device__ void operator()(int r, int c, float a) const { float* p = out + (size_t)r * D + c; *p = ALPHA * (*p) + a + b[c]; } };
}

__device__ __forceinline__ int fresh_tid(int wave_s) { unsigned m = ~0u; asm volatile("" : "+s"(m)); return wave_s * 64 + (int)__builtin_amdgcn_mbcnt_hi(m, __builtin_amdgcn_mbcnt_lo(m, 0u)); }
namespace pg8 {
#define PG8_LAS __attribute__((address_space(3)))
typedef short bf16x8 __attribute__((ext_vector_type(8)));
typedef float f32x4 __attribute__((ext_vector_type(4)));
typedef unsigned u32x4 __attribute__((ext_vector_type(4)));
typedef unsigned u32x2 __attribute__((ext_vector_type(2)));
constexpr int BM = 256, BK = 64, HALF = 128, HTB = HALF * BK * 2  , STAGE_BYTES = 8 * HTB, NXCD = 8, WGM = 8;
__host__ __device__ __forceinline__ int lds_byte(int r, int c) { const int st = (r >> 4) * 2 + (c >> 5), rr = r & 15, cc = c & 31, ob = rr * 64 + cc * 2; return st * 1024 + (ob ^ (((ob >> 9) & 1) << 5)); }
__host__ __device__ __forceinline__ void stage_rc(int b, int& R, int& C) { const int st = b / 1024, sb = b % 1024, swz = sb ^ (((sb >> 9) & 1) << 5); R = (st >> 1) * 16 + swz / 64; C = (st & 1) * 32 + (swz % 64) / 2; }
__host__ __device__ __forceinline__ int perm32(int rho) { const int n = rho >> 4, i = rho & 15; return 8 * (i >> 2) + 4 * n + (i & 3); }
struct Unit { int pm, pn; };
struct Gemm { const bf16_t* A; int lda; const bf16_t* Bt; int ldb; int M, N, K; };
struct StaticOrder {
    int nM, nN, nwg, G, c;
    __host__ __device__ void init(int M_, int N_, int G_, int c_) { nM = M_ / BM; nN = N_ / BM; nwg = nM * nN; G = G_; c = c_; }
    __host__ __device__ bool next(int i, Unit& u) const {
        const long L = (long)i * G + c; if (L >= nwg) return false;
        int wgid = (int)L; { const int q = nwg / NXCD, r = nwg % NXCD, xcd = wgid % NXCD, off = wgid / NXCD; wgid = (xcd < r ? xcd * (q + 1) : r * (q + 1) + (xcd - r) * q) + off; }
        const int nig = WGM * nN, gid = wgid / nig, fm = gid * WGM, gsz = (nM - fm) < WGM ? (nM - fm) : WGM;
        u.pm = fm + ((wgid % nig) % gsz); u.pn = (wgid % nig) / gsz; return true;
    }
    __device__ __forceinline__ void a_ready(const Unit&) const {}
    __device__ __forceinline__ void done(const Unit&) const {}
};
__device__ __forceinline__ unsigned cvt_pk_bf16(float lo, float hi) { unsigned r; asm volatile("v_cvt_pk_bf16_f32 %0, %1, %2" : "=v"(r) : "v"(lo), "v"(hi)); return r; }
__device__ __forceinline__ float bf_lo(unsigned w) { return __uint_as_float(w << 16); }
__device__ __forceinline__ float bf_hi(unsigned w) { return __uint_as_float(w & 0xffff0000u); }
__device__ __forceinline__ float sigm(float x) { return __builtin_amdgcn_rcpf(1.f + __expf(-x)); }
__device__ __forceinline__ float gelu_t(float x) { const float u = 1.5957691216057308f * (x + 0.044715f * x * x * x); return x * sigm(u); }

struct EpiZ {
    static constexpr bool PERM = true, AFTER_DRAIN = false, IDEMP = true;
    bf16_t* Z;
    __device__ __forceinline__ void operator()(const f32x4 (&acc)[2][2][4][2], const Unit& u, int wr, int wc, int fr, int fq) const {
        const int row0 = u.pm * BM + wr * 64 + fr, col0 = u.pn * BM + wc * 32 + 8 * fq;
        const int act = (u.pn >= 20) ? 2 : ((u.pn >= 8 && u.pn < 16) ? 1 : 0);
#pragma unroll
        for (int ai = 0; ai < 2; ++ai)
#pragma unroll
            for (int m = 0; m < 4; ++m) { bf16_t* rowp = Z + (size_t)(row0 + ai * HALF + m * 16) * DIN + col0;
#pragma unroll
                for (int bj = 0; bj < 2; ++bj) { f32x4 v0 = acc[ai][bj][m][0], v1 = acc[ai][bj][m][1];
                    if (act == 1) {
#pragma unroll
                        for (int j = 0; j < 4; ++j) { v0[j] = gelu_t(v0[j]); v1[j] = gelu_t(v1[j]); } }
                    else if (act == 2) {
#pragma unroll
                        for (int j = 0; j < 4; ++j) { v0[j] = sigm(v0[j]); v1[j] = sigm(v1[j]); } }
                    u32x4 w; w.x = cvt_pk_bf16(v0[0], v0[1]); w.y = cvt_pk_bf16(v0[2], v0[3]); w.z = cvt_pk_bf16(v1[0], v1[1]); w.w = cvt_pk_bf16(v1[2], v1[3]);
                    *(u32x4*)(rowp + bj * HALF) = w; } }
    }
};
struct EpiGlu {
    static constexpr bool PERM = true, AFTER_DRAIN = false, IDEMP = false;
    bf16_t* Z;
    __device__ __forceinline__ void operator()(const f32x4 (&acc)[2][2][4][2], const Unit& u, int wr, int wc, int fr, int fq) const {
        const int row0 = u.pm * BM + wr * 64 + fr, col0 = u.pn * HALF + wc * 32 + 8 * fq;
#pragma unroll
        for (int ai = 0; ai < 2; ++ai)
#pragma unroll
            for (int m = 0; m < 4; ++m) { bf16_t* p = Z + (size_t)(row0 + ai * HALF + m * 16) * DIN + O_GB + col0;
                const u32x4 g = *(const u32x4*)p;
                const f32x4 w0 = acc[ai][0][m][0], w1 = acc[ai][0][m][1], v0 = acc[ai][1][m][0], v1 = acc[ai][1][m][1];
                u32x4 o;
                o.x = cvt_pk_bf16(w0[0] * sigm(v0[0]) * bf_lo(g.x), w0[1] * sigm(v0[1]) * bf_hi(g.x));
                o.y = cvt_pk_bf16(w0[2] * sigm(v0[2]) * bf_lo(g.y), w0[3] * sigm(v0[3]) * bf_hi(g.y));
                o.z = cvt_pk_bf16(w1[0] * sigm(v1[0]) * bf_lo(g.z), w1[1] * sigm(v1[1]) * bf_hi(g.z));
                o.w = cvt_pk_bf16(w1[2] * sigm(v1[2]) * bf_lo(g.w), w1[3] * sigm(v1[3]) * bf_hi(g.w));
                *(u32x4*)p = o; }
    }
};
struct EpiMix {
    static constexpr bool PERM = true, AFTER_DRAIN = false, IDEMP = false;
    bf16_t* Z;
    __device__ __forceinline__ void operator()(const f32x4 (&acc)[2][2][4][2], const Unit& u, int wr, int wc, int fr, int fq) const {
        const int row0 = u.pm * BM + wr * 64 + fr, col0 = u.pn * BM + wc * 32 + 8 * fq;
#pragma unroll
        for (int ai = 0; ai < 2; ++ai)
#pragma unroll
            for (int m = 0; m < 4; ++m) { bf16_t* rowp = Z + (size_t)(row0 + ai * HALF + m * 16) * DIN + col0;
#pragma unroll
                for (int bj = 0; bj < 2; ++bj) { bf16_t* pa = rowp + O_GA + bj * HALF; const bf16_t* pb = rowp + O_GB + bj * HALF;
                    const u32x4 ga = *(const u32x4*)pa, yb = *(const u32x4*)pb; const f32x4 a0 = acc[ai][bj][m][0], a1 = acc[ai][bj][m][1];
                    u32x4 o;
                    o.x = cvt_pk_bf16(bf_lo(ga.x) * a0[0] + bf_lo(yb.x), bf_hi(ga.x) * a0[1] + bf_hi(yb.x));
                    o.y = cvt_pk_bf16(bf_lo(ga.y) * a0[2] + bf_lo(yb.y), bf_hi(ga.y) * a0[3] + bf_hi(yb.y));
                    o.z = cvt_pk_bf16(bf_lo(ga.z) * a1[0] + bf_lo(yb.z), bf_hi(ga.z) * a1[1] + bf_hi(yb.z));
                    o.w = cvt_pk_bf16(bf_lo(ga.w) * a1[2] + bf_lo(yb.w), bf_hi(ga.w) * a1[3] + bf_hi(yb.w));
                    *(u32x4*)pa = o; } }
    }
};
struct EpiR1 {
    static constexpr bool PERM = false, AFTER_DRAIN = false, IDEMP = true;
    const float* x; float* out;
    __device__ __forceinline__ void operator()(const f32x4 (&acc)[2][2][4][2], const Unit& u, int wr, int wc, int fr, int fq) const {
        const int row0 = u.pm * BM + wr * 64 + fr, col0 = u.pn * BM + wc * 32 + 4 * fq;
#pragma unroll
        for (int ai = 0; ai < 2; ++ai)
#pragma unroll
            for (int m = 0; m < 4; ++m) { const size_t off = (size_t)(row0 + ai * HALF + m * 16) * D + col0;
#pragma unroll
                for (int bj = 0; bj < 2; ++bj)
#pragma unroll
                    for (int n = 0; n < 2; ++n) { const f32x4 xv = *(const f32x4*)(x + off + bj * HALF + n * 16); *(f32x4*)(out + off + bj * HALF + n * 16) = xv * ALPHA + acc[ai][bj][m][n]; }
                asm volatile("" ::: "memory"); }
    }
};
struct EpiUp {
    static constexpr bool PERM = true, AFTER_DRAIN = false, IDEMP = true;
    bf16_t* H; const float* bias;
    __device__ __forceinline__ void operator()(const f32x4 (&acc)[2][2][4][2], const Unit& u, int wr, int wc, int fr, int fq) const {
        const int row0 = u.pm * BM + wr * 64 + fr, col0 = u.pn * BM + wc * 32 + 8 * fq;
        f32x4 bv[2][2];
#pragma unroll
        for (int bj = 0; bj < 2; ++bj)
#pragma unroll
            for (int n = 0; n < 2; ++n) bv[bj][n] = *(const f32x4*)(bias + col0 + bj * HALF + 4 * n);
#pragma unroll
        for (int ai = 0; ai < 2; ++ai)
#pragma unroll
            for (int m = 0; m < 4; ++m) { bf16_t* rowp = H + (size_t)(row0 + ai * HALF + m * 16) * DFF + col0;
#pragma unroll
                for (int bj = 0; bj < 2; ++bj) { f32x4 v0 = acc[ai][bj][m][0] + bv[bj][0], v1 = acc[ai][bj][m][1] + bv[bj][1];
#pragma unroll
                    for (int j = 0; j < 4; ++j) { v0[j] = fmaxf(v0[j], 0.f); v0[j] *= v0[j]; v1[j] = fmaxf(v1[j], 0.f); v1[j] *= v1[j]; }
                    u32x4 w; w.x = cvt_pk_bf16(v0[0], v0[1]); w.y = cvt_pk_bf16(v0[2], v0[3]); w.z = cvt_pk_bf16(v1[0], v1[1]); w.w = cvt_pk_bf16(v1[2], v1[3]);
                    *(u32x4*)(rowp + bj * HALF) = w; } }
    }
};
struct EpiR2 {
    static constexpr bool PERM = false, AFTER_DRAIN = false, IDEMP = false;
    float* out; const float* bias;
    __device__ __forceinline__ void operator()(const f32x4 (&acc)[2][2][4][2], const Unit& u, int wr, int wc, int fr, int fq) const {
        const int row0 = u.pm * BM + wr * 64 + fr, col0 = u.pn * BM + wc * 32 + 4 * fq;
        f32x4 bv[2][2];
#pragma unroll
        for (int bj = 0; bj < 2; ++bj)
#pragma unroll
            for (int n = 0; n < 2; ++n) bv[bj][n] = *(const f32x4*)(bias + col0 + bj * HALF + n * 16);
#pragma unroll
        for (int ai = 0; ai < 2; ++ai)
#pragma unroll
            for (int m = 0; m < 4; ++m) { const size_t off = (size_t)(row0 + ai * HALF + m * 16) * D + col0;
#pragma unroll
                for (int bj = 0; bj < 2; ++bj)
#pragma unroll
                    for (int n = 0; n < 2; ++n) { float* p = out + off + bj * HALF + n * 16; const f32x4 xv = *(const f32x4*)p; *(f32x4*)p = xv * ALPHA + acc[ai][bj][m][n] + bv[bj][n]; }
                asm volatile("" ::: "memory"); }
    }
};

template <class Epi, class Sched, bool ALIGN_EPI = true>
__device__ __forceinline__ void gemm_phase(PG8_LAS unsigned char* lds, const Gemm g, const Sched& S, const Epi& E, int wave_s) {
    const int tid = fresh_tid(wave_s);
    const int wid = __builtin_amdgcn_readfirstlane(tid >> 6), lane = tid & 63, wr = wid >> 2, wc = wid & 3, fr = lane & 15, fq = lane >> 4;
    const int K = g.K, nt = K / BK;
    unsigned voffA[2], voffB[2];
#pragma unroll
    for (int i = 0; i < 2; ++i) { int R, C; stage_rc(tid * 16 + i * 8192, R, C); const int Rb = Epi::PERM ? ((R & ~31) + perm32(R & 31)) : R;
        voffA[i] = (unsigned)(R * g.lda + C) * 2u; voffB[i] = (unsigned)(Rb * g.ldb + C) * 2u; }
    const size_t kstep = (size_t)(BK * 2);
    const size_t hstepA = (size_t)HALF * g.lda * 2, hstepB = (size_t)HALF * g.ldb * 2;
    const size_t tstepA = 2 * hstepA, tstepB = 2 * hstepB;
    const unsigned ldsw = (unsigned)wid * 1024u;
    const int aoff = lds_byte(wr * 64 + fr, fq * 8), boff = lds_byte(wc * 32 + fr, fq * 8);
#define PG8_SA(b, h) (((b) * 2 + (h)) * HTB)
#define PG8_SB(b, h) ((4 + (b) * 2 + (h)) * HTB)
#define PG8_STAGE(bufoff, gbase, voff) do { _Pragma("unroll") for (int _i = 0; _i < 2; ++_i) \
        __builtin_amdgcn_global_load_lds((const unsigned*)((const char*)(gbase) + (voff)[_i]), (PG8_LAS unsigned*)(lds + (bufoff) + ldsw + _i * 8192), 16, 0, 0); } while (0)
#define PG8_LDA(dst, b, h) do { _Pragma("unroll") for (int m = 0; m < 4; ++m) _Pragma("unroll") for (int k = 0; k < 2; ++k) dst[m][k] = *(const PG8_LAS bf16x8*)(lds + PG8_SA(b, h) + aoff + m * 2048 + k * 1024); } while (0)
#define PG8_LDB(dst, b, h) do { _Pragma("unroll") for (int n = 0; n < 2; ++n) _Pragma("unroll") for (int k = 0; k < 2; ++k) dst[n][k] = *(const PG8_LAS bf16x8*)(lds + PG8_SB(b, h) + boff + n * 2048 + k * 1024); } while (0)
#define PG8_MMA(ai, bj, At, Bt) do { __builtin_amdgcn_s_setprio(1); _Pragma("unroll") for (int m = 0; m < 4; ++m) _Pragma("unroll") for (int n = 0; n < 2; ++n) _Pragma("unroll") for (int k = 0; k < 2; ++k) \
        acc[ai][bj][m][n] = __builtin_amdgcn_mfma_f32_16x16x32_bf16(Bt[n][k], At[m][k], acc[ai][bj][m][n], 0, 0, 0); __builtin_amdgcn_s_setprio(0); } while (0)
#define PG8_WAIT_V(n) asm volatile("s_waitcnt vmcnt(" #n ")" ::: "memory")
#define PG8_WAIT_L(n) asm volatile("s_waitcnt lgkmcnt(" #n ")" ::: "memory")
#define PG8_BAR __builtin_amdgcn_s_barrier()
#define PG8_SCHED __builtin_amdgcn_sched_barrier(0)
    Unit cur, nxt; int ui = 0;
    if (!S.next(0, cur)) return;
    f32x4 acc[2][2][4][2];
#pragma unroll
    for (int a = 0; a < 2; ++a)
#pragma unroll
        for (int b = 0; b < 2; ++b)
#pragma unroll
            for (int m = 0; m < 4; ++m)
#pragma unroll
                for (int n = 0; n < 2; ++n) acc[a][b][m][n] = (f32x4){0.f, 0.f, 0.f, 0.f};
    bf16x8 At[4][2], B0[2][2], B1[2][2];
    const char* cA = (const char*)g.A + (size_t)cur.pm * tstepA; const char* cB = (const char*)g.Bt + (size_t)cur.pn * tstepB;
    S.a_ready(cur);
    PG8_STAGE(PG8_SB(0, 0), cB, voffB); PG8_STAGE(PG8_SB(0, 1), cB + hstepB, voffB); PG8_STAGE(PG8_SA(0, 0), cA, voffA); PG8_STAGE(PG8_SA(0, 1), cA + hstepA, voffA);
    if (wr == 1) PG8_BAR;
    PG8_WAIT_V(2); PG8_BAR;
    PG8_STAGE(PG8_SB(1, 0), cB + kstep, voffB); PG8_STAGE(PG8_SA(1, 0), cA + kstep, voffA); PG8_STAGE(PG8_SB(1, 1), cB + hstepB + kstep, voffB);
    PG8_WAIT_V(6); PG8_BAR;
    for (;;) {
        const bool has_next = S.next(ui + 1, nxt);
        const char* nA = has_next ? (const char*)g.A + (size_t)nxt.pm * tstepA : cA; const char* nB = has_next ? (const char*)g.Bt + (size_t)nxt.pn * tstepB : cB;
        for (int t = 0; t < nt; t += 2) {
            const bool last = (t == nt - 2);
            const char* a1 = cA + (size_t)(t + 1) * kstep;
            const char* a2 = last ? nA : cA + (size_t)(t + 2) * kstep; const char* b2 = last ? nB : cB + (size_t)(t + 2) * kstep;
            const char* a3 = a2 + kstep; const char* b3 = b2 + kstep;
            if (last && has_next) S.a_ready(nxt);
            PG8_LDB(B0, 0, 0); PG8_LDB(B1, 0, 1); PG8_SCHED; PG8_LDA(At, 0, 0); PG8_STAGE(PG8_SA(1, 1), a1 + hstepA, voffA);
            PG8_WAIT_V(8); PG8_WAIT_L(0); PG8_BAR; PG8_MMA(0, 0, At, B0); PG8_MMA(0, 1, At, B1); PG8_BAR; PG8_SCHED;
            PG8_LDA(At, 0, 1); PG8_STAGE(PG8_SB(0, 0), b2, voffB); PG8_STAGE(PG8_SB(0, 1), b2 + hstepB, voffB); PG8_STAGE(PG8_SA(0, 0), a2, voffA);
            PG8_WAIT_V(8); PG8_WAIT_L(0); PG8_BAR; PG8_MMA(1, 0, At, B0); PG8_MMA(1, 1, At, B1); PG8_BAR; PG8_SCHED;
            PG8_LDB(B0, 1, 0); PG8_LDB(B1, 1, 1); PG8_SCHED; PG8_LDA(At, 1, 0); PG8_STAGE(PG8_SA(0, 1), a2 + hstepA, voffA);
            PG8_WAIT_V(8); PG8_WAIT_L(0); PG8_BAR; PG8_MMA(0, 0, At, B0); PG8_MMA(0, 1, At, B1); PG8_BAR; PG8_SCHED;
            PG8_LDA(At, 1, 1); PG8_STAGE(PG8_SB(1, 0), b3, voffB); PG8_STAGE(PG8_SB(1, 1), b3 + hstepB, voffB); PG8_STAGE(PG8_SA(1, 0), a3, voffA);
            PG8_WAIT_V(8); PG8_WAIT_L(0); PG8_BAR; PG8_MMA(1, 0, At, B0); PG8_MMA(1, 1, At, B1); PG8_BAR; PG8_SCHED;
        }
        if constexpr (ALIGN_EPI) { if (wr == 0) PG8_BAR; }
        E(acc, cur, wr, wc, fr, fq); S.done(cur);
#if defined(MK_EPI2)
        if constexpr (Epi::IDEMP) { asm volatile("" ::: "memory"); E(acc, cur, wr, wc, fr, fq); }
#endif
        if (!has_next) break;
#pragma unroll
        for (int a = 0; a < 2; ++a)
#pragma unroll
            for (int b = 0; b < 2; ++b)
#pragma unroll
                for (int m = 0; m < 4; ++m)
#pragma unroll
                    for (int n = 0; n < 2; ++n) acc[a][b][m][n] = (f32x4){0.f, 0.f, 0.f, 0.f};
        cur = nxt; cA = nA; cB = nB; ++ui;
        if constexpr (ALIGN_EPI) { if (wr == 1) PG8_BAR; }
    }
    PG8_WAIT_V(0);
    if constexpr (!ALIGN_EPI) { if (wr == 0) PG8_BAR; }
    PG8_BAR;
#undef PG8_SA
#undef PG8_SB
#undef PG8_STAGE
#undef PG8_LDA
#undef PG8_LDB
#undef PG8_MMA
#undef PG8_WAIT_V
#undef PG8_WAIT_L
#undef PG8_BAR
#undef PG8_SCHED
}
}

namespace scan {
#define SLAS __attribute__((address_space(3)))
typedef short bf16x8 __attribute__((ext_vector_type(8)));
typedef float f32x16 __attribute__((ext_vector_type(16)));
typedef float f32x4 __attribute__((ext_vector_type(4)));
typedef unsigned u32x4 __attribute__((ext_vector_type(4)));
typedef unsigned u32x2 __attribute__((ext_vector_type(2)));
typedef __bf16 bf16x2v __attribute__((ext_vector_type(2)));
typedef float f32x2v __attribute__((ext_vector_type(2)));
#define MFMA32(a, b, c) __builtin_amdgcn_mfma_f32_32x32x16_bf16((a), (b), (c), 0, 0, 0)
__device__ __forceinline__ unsigned pk2c(float a, float b) { f32x2v f = {a, b}; bf16x2v r = __builtin_convertvector(f, bf16x2v); return __builtin_bit_cast(unsigned, r); }
__device__ __forceinline__ bf16x8 pack8(float a0, float a1, float a2, float a3, float a4, float a5, float a6, float a7) {
    u32x4 p; p.x = pk2c(a0, a1); p.y = pk2c(a2, a3); p.z = pk2c(a4, a5); p.w = pk2c(a6, a7); return __builtin_bit_cast(bf16x8, p); }
__device__ __forceinline__ int crow(int i, int hf) { return (i & 3) + 8 * (i >> 2) + 4 * hf; }
__device__ __forceinline__ float sigm(float x) { return __builtin_amdgcn_rcpf(1.f + __expf(-x)); }
__device__ __forceinline__ float gelu_t(float x) { const float u = 1.5957691216057308f * (x + 0.044715f * x * x * x); return x * sigm(u); }

constexpr int RG_NC = 32, RG_L = SEQ / RG_NC, RG_STEPS = RG_L / 16, RG_NS = NB * RG_NC;
constexpr int S5_NC = 256, S5_L = SEQ / S5_NC, S5_NS = NB * S5_NC, S5_UNITS = (S5_NS / 32) * NG;
constexpr size_t WS_RGP = WS_X1B, WS_RGS = WS_RGP + 512 * 1024, WS_RGH = WS_RGS + 512 * 1024;
constexpr size_t WS_S5S = WS_X1B + 2 * MiB, WS_S5H = WS_S5S + 16 * MiB;
static_assert(WS_S5H + 16 * MiB <= WS_Z, "scan scratch fits the X1B region");

constexpr float LOG2E = 1.4426950408889634f;
__device__ __forceinline__ void rglru_pack_weights(const float* __restrict__ wa, const float* __restrict__ wx, bf16_t* RGW, int idx) {
    const int lane = idx & 63, ks = (idx >> 6) & 7, gate = (idx >> 9) & 1, w4 = (idx >> 10) & 3, hd = idx >> 12;
    const float* p = (gate ? wx : wa) + (size_t)hd * HD * HD + (size_t)(16 * ks + 8 * (lane >> 5)) * HD + w4 * 32 + (lane & 31);
    ((bf16x8*)RGW)[idx] = pack8(-LOG2E * p[0], -LOG2E * p[HD], -LOG2E * p[2 * HD], -LOG2E * p[3 * HD], -LOG2E * p[4 * HD], -LOG2E * p[5 * HD], -LOG2E * p[6 * HD], -LOG2E * p[7 * HD]);
}
constexpr int RG_T_BYTES = 8704, RG_HB_LDS = 4 * RG_T_BYTES;
constexpr unsigned ROWB = DIN * 2;
#define RG_BARRIER() do { asm volatile("s_waitcnt lgkmcnt(0)" ::: "memory"); __builtin_amdgcn_s_barrier(); asm volatile("" ::: "memory"); } while (0)
template <bool PASS_B, bool DRY = false>
__device__ __forceinline__ void rglru_pass(SLAS unsigned char* lds, bf16_t* Z, const float* __restrict__ conv_w, const float* __restrict__ conv_b, const bf16_t* __restrict__ RGW, const float* __restrict__ ba,
                                           const float* __restrict__ bxp, const float* __restrict__ lam, float* RGP, float* RGS, const float* RGH, int bx, int G, int wave_s, bf16_t* dry = nullptr) {
    const int tid = fresh_tid(wave_s);
    const int lane = tid & 63, wave = wave_s, hb = wave >> 2, w4 = wave & 3;
    const int col = lane & 31, hf = lane >> 5;
    SLAS unsigned char* base = lds + hb * RG_HB_LDS;
#define RG_A(i) (base + (i) * RG_T_BYTES)
#define RG_G() (base + 2 * RG_T_BYTES)
#define RG_H() (base + 3 * RG_T_BYTES)
    const __amdgpu_buffer_rsrc_t zr = __builtin_amdgcn_make_buffer_rsrc(Z, 0, 0x7fffffff, 0x00020000);
    const __amdgpu_buffer_rsrc_t zw = DRY ? __builtin_amdgcn_make_buffer_rsrc(dry, 0, 0x7fffffff, 0x00020000) : zr;
    for (int ub = bx; ub < 256; ub += G) {
        const int unit = 2 * ub + hb, hd = unit & 15, sp = unit >> 4;
        const int cs = w4 >> 1, th = w4 & 1, cp = lane, s_conv = 2 * sp + cs, chc = hd * HD + 2 * cp;
        const int cconv = s_conv % RG_NC;
        const unsigned tok0 = (unsigned)((s_conv / RG_NC) * SEQ + cconv * RG_L);
        const unsigned vgc = (tok0 * DIN + O_GR + chc) * 2u;
        const unsigned vx3 = (tok0 * DIN + O_XR + chc) * 2u - (cconv > 0 ? 3u * ROWB : 0u);
        const int radj = cconv > 0 ? 0 : -3;
        const float2 cw0 = *(const float2*)(conv_w + 0 * D + chc), cw1 = *(const float2*)(conv_w + 1 * D + chc), cw2 = *(const float2*)(conv_w + 2 * D + chc), cw3 = *(const float2*)(conv_w + 3 * D + chc), cbv = *(const float2*)(conv_b + chc);
        const unsigned iooff = (unsigned)(4 * cs * 272 + 4 * cp);
        const int s_scan = 2 * sp + hf, ch = hd * HD + w4 * 32 + col;
        const float nba = -LOG2E * ba[ch], nbx = -LOG2E * bxp[ch], lac2 = -8.f * LOG2E * log1pf(expf(-lam[ch]));
        const unsigned scoff = (unsigned)(4 * hf * 272 + (w4 * 32 + col) * 2);
        bf16x8 Br[8], Bi[8];
        {
            const bf16x8* wf = (const bf16x8*)RGW + (size_t)((hd * 4 + w4) * 2) * 8 * 64 + lane;
#pragma unroll
            for (int ks = 0; ks < 8; ++ks) { Br[ks] = wf[ks * 64]; Bi[ks] = wf[(8 + ks) * 64]; }
        }
        float h = PASS_B ? RGH[(size_t)s_scan * D + ch] : 0.f, P = 1.f;
        unsigned X[11], GV[8];
        f32x16 accR, accI;
#define RG_TROW(k) (((k) & 3) + 8 * ((k) >> 2))
#define RG_LOADX(st) do { _Pragma("unroll") for (int j = 0; j < 11; ++j) { const int ridx = 16 * (st) + 8 * th + j + radj; \
            X[j] = (ridx >= 0) ? __builtin_amdgcn_raw_buffer_load_b32(zr, vx3, (unsigned)ridx * ROWB, 0) : 0u; } } while (0)
#define RG_LOADG(st) do { _Pragma("unroll") for (int j = 0; j < 8; ++j) GV[j] = __builtin_amdgcn_raw_buffer_load_b32(zr, vgc, (unsigned)(16 * (st) + 8 * th + j) * ROWB, 0); } while (0)
#define RG_CONV(st) do { SLAS unsigned char* At = RG_A((st) & 1) + iooff; float xl[11], xh[11]; \
            _Pragma("unroll") for (int j = 0; j < 11; ++j) { xl[j] = __uint_as_float(X[j] << 16); xh[j] = __uint_as_float(X[j] & 0xffff0000u); } \
            _Pragma("unroll") for (int j = 0; j < 8; ++j) { \
                const float c0 = fmaf(cw0.x, xl[j], fmaf(cw1.x, xl[j + 1], fmaf(cw2.x, xl[j + 2], fmaf(cw3.x, xl[j + 3], cbv.x)))); \
                const float c1 = fmaf(cw0.y, xh[j], fmaf(cw1.y, xh[j + 1], fmaf(cw2.y, xh[j + 2], fmaf(cw3.y, xh[j + 3], cbv.y)))); \
                *(SLAS unsigned*)(At + RG_TROW(8 * th + j) * 272) = pk2c(c0, c1); } } while (0)
#define RG_PUTG() do { SLAS unsigned char* Gt = RG_G() + iooff; _Pragma("unroll") for (int j = 0; j < 8; ++j) *(SLAS unsigned*)(Gt + RG_TROW(8 * th + j) * 272) = GV[j]; } while (0)
#define RG_COPYOUT(st) do { const SLAS unsigned char* Ht = RG_H() + iooff; _Pragma("unroll") for (int j = 0; j < 8; ++j) \
            __builtin_amdgcn_raw_buffer_store_b32(*(const SLAS unsigned*)(Ht + RG_TROW(8 * th + j) * 272), zw, DRY ? (vgc & 0x3ffffffu) : vgc, (unsigned)(16 * (st) + 8 * th + j) * ROWB, 0); } while (0)
#define RG_MFMA(st) do { const SLAS unsigned char* At = RG_A((st) & 1); \
            _Pragma("unroll") for (int i = 0; i < 16; ++i) { accR[i] = nba; accI[i] = nbx; } \
            _Pragma("unroll") for (int ks = 0; ks < 8; ++ks) { const bf16x8 af = *(const SLAS bf16x8*)(At + col * 272 + (16 * ks + 8 * hf) * 2); accR = MFMA32(af, Br[ks], accR); accI = MFMA32(af, Bi[ks], accI); } } while (0)
#define RG_GATES(st) do { const SLAS unsigned char* Ax = RG_A((st) & 1) + scoff; const SLAS unsigned char* Gx = RG_G() + scoff; SLAS unsigned char* Hx = RG_H() + scoff; \
            _Pragma("unroll") for (int i = 0; i < 16; ++i) { \
                const float xc = bf2f(*(const SLAS bf16_t*)(Ax + RG_TROW(i) * 272)); \
                const float r = __builtin_amdgcn_rcpf(1.f + __builtin_amdgcn_exp2f(accR[i])), ig = __builtin_amdgcn_rcpf(1.f + __builtin_amdgcn_exp2f(accI[i])); \
                const float av = __builtin_amdgcn_exp2f(r * lac2); \
                const float mult = __builtin_amdgcn_sqrtf(fmaf(-av, av, 1.f)); \
                h = fmaf(av, h, (mult * ig) * xc); \
                if (PASS_B) { const float gv = bf2f(*(const SLAS bf16_t*)(Gx + RG_TROW(i) * 272)); *(SLAS bf16_t*)(Hx + RG_TROW(i) * 272) = (bf16_t)(pk2c(h * gv, 0.f) & 0xffffu); } \
                else P *= av; } } while (0)
        RG_LOADX(0); if (PASS_B) RG_LOADG(0);
        RG_CONV(0);
        RG_LOADX(1);
        RG_BARRIER();
        for (int p = 0; p < 2 * RG_STEPS + 2; ++p) {
            const int q = p - 1 - hb;
            if (q >= -1 && q <= 2 * RG_STEPS - 1) {
                if (q & 1) {
                    const int t = (q - 1) >> 1;
                    if (PASS_B && t >= 0) RG_COPYOUT(t);
                    if (t + 1 < RG_STEPS) RG_MFMA(t + 1);
                    if (t + 2 < RG_STEPS) RG_CONV(t + 2);
                    if (PASS_B && t + 1 < RG_STEPS) RG_PUTG();
                    if (t + 3 < RG_STEPS) RG_LOADX(t + 3);
                    if (PASS_B && t + 2 < RG_STEPS) RG_LOADG(t + 2);
                } else {
                    RG_GATES(q >> 1);
                }
            }
            RG_BARRIER();
        }
        if (!PASS_B) { RGP[(size_t)s_scan * D + ch] = P; RGS[(size_t)s_scan * D + ch] = h; }
#undef RG_TROW
#undef RG_LOADX
#undef RG_LOADG
#undef RG_CONV
#undef RG_PUTG
#undef RG_COPYOUT
#undef RG_MFMA
#undef RG_GATES
    }
#undef RG_A
#undef RG_G
#undef RG_H
}
__device__ __forceinline__ void rglru_carry(const float* RGP, const float* RGS, float* RGH, int idx) {
    const int b = idx / D, ch = idx % D; float H = 0.f;
#pragma unroll 8
    for (int c = 0; c < RG_NC; ++c) { const size_t o = (size_t)(b * RG_NC + c) * D + ch; RGH[o] = H; H = RGP[o] * H + RGS[o]; }
}

__device__ __forceinline__ size_t s5_idx(int g, int T, int row, int s) { return ((size_t)(g * 128 + (T >> 1) * 64 + (T & 1) * 32 + row)) * S5_NS + s; }
template <bool PASS_B>
__device__ __forceinline__ void s5_pass(bf16_t* Z, const float2* __restrict__ lamtab, const float* __restrict__ bbr, const float* __restrict__ bbi, const float* __restrict__ c_re, const float* __restrict__ c_im,
                                        const float* __restrict__ dd, float* S5S, const float* S5H, SLAS f32x2v* ltab  , int gw, int NGW, int lane) {
    const int col = lane & 31, hf = lane >> 5;
    for (int unit = gw; unit < S5_UNITS; unit += NGW) {
        const int g = unit & (NG - 1), sset = unit / NG;
        const int s = sset * 32 + col, b = s / S5_NC, c = s % S5_NC;
        bf16_t* zu = Z + ((size_t)b * SEQ + (size_t)c * S5_L) * DIN + O_U + g * GS;
        bf16x8 Ab[4];
#pragma unroll
        for (int T = 0; T < 4; ++T) { const float* src = ((T >> 1) ? bbi : bbr) + (size_t)(g * NP + 32 * (T & 1) + col) * GS + 8 * hf;
            Ab[T] = pack8(src[0], src[1], src[2], src[3], src[4], src[5], src[6], src[7]); }
        { const int e_hf = lane >> 5, e_tp = (lane >> 4) & 1, e_i = lane & 15; const float2 lv = lamtab[g * NP + 32 * e_tp + crow(e_i, e_hf)]; f32x2v lw = {lv.x, lv.y}; ltab[lane] = lw; }
        f32x16 h[4];
#pragma unroll
        for (int T = 0; T < 4; ++T)
#pragma unroll
            for (int i = 0; i < 16; ++i) h[T][i] = PASS_B ? S5H[s5_idx(g, T, crow(i, hf), s)] : 0.f;
        bf16x8 Ac[4][2], Adh, Adl;
        if (PASS_B) {
            const int hp = col & 15; const bool live = col < 16;
#pragma unroll
            for (int T = 0; T < 4; ++T)
#pragma unroll
                for (int sk = 0; sk < 2; ++sk) { float v[8];
#pragma unroll
                    for (int j = 0; j < 8; ++j) { const int p = 32 * (T & 1) + 16 * sk + 8 * (j >> 2) + 4 * hf + (j & 3);
                        const float cv = (T < 2) ? c_re[(size_t)(g * GS + hp) * NP + p] : -c_im[(size_t)(g * GS + hp) * NP + p]; v[j] = live ? cv : 0.f; }
                    Ac[T][sk] = pack8(v[0], v[1], v[2], v[3], v[4], v[5], v[6], v[7]); }
            const float dv = dd[g * GS + hp]; const float dhi = __uint_as_float(pk2c(dv, 0.f) << 16), dlo = dv - dhi;
            float vh[8], vl[8];
#pragma unroll
            for (int j = 0; j < 8; ++j) { const bool on = live && (hp == 8 * hf + j); vh[j] = on ? dhi : 0.f; vl[j] = on ? dlo : 0.f; }
            Adh = pack8(vh[0], vh[1], vh[2], vh[3], vh[4], vh[5], vh[6], vh[7]); Adl = pack8(vl[0], vl[1], vl[2], vl[3], vl[4], vl[5], vl[6], vl[7]);
        }
        bf16x8 u = *(const bf16x8*)(zu + 8 * hf);
        for (int step = 0; step < S5_L; ++step) {
            bf16x8 un = u;
            if (step + 1 < S5_L) un = *(const bf16x8*)(zu + (size_t)(step + 1) * DIN + 8 * hf);
            asm volatile("" ::: "memory");
#pragma unroll
            for (int tp = 0; tp < 2; ++tp) { f32x16 tr, ti;
#pragma unroll
                for (int i = 0; i < 16; i += 2) { const f32x4 l2 = *(const SLAS f32x4*)(ltab + (hf * 2 + tp) * 16 + i);
                    tr[i] = l2[0] * h[tp][i] - l2[1] * h[tp + 2][i]; ti[i] = l2[0] * h[tp + 2][i] + l2[1] * h[tp][i];
                    tr[i + 1] = l2[2] * h[tp][i + 1] - l2[3] * h[tp + 2][i + 1]; ti[i + 1] = l2[2] * h[tp + 2][i + 1] + l2[3] * h[tp][i + 1]; }
                h[tp] = MFMA32(Ab[tp], u, tr); h[tp + 2] = MFMA32(Ab[tp + 2], u, ti);
                __builtin_amdgcn_sched_barrier(0); }
            if (PASS_B) {
                f32x16 y;
#pragma unroll
                for (int i = 0; i < 16; ++i) y[i] = 0.f;
                y = MFMA32(Adh, u, y); y = MFMA32(Adl, u, y);
#pragma unroll
                for (int T = 0; T < 4; ++T)
#pragma unroll
                    for (int sk = 0; sk < 2; ++sk) { const bf16x8 xb = pack8(h[T][8 * sk], h[T][8 * sk + 1], h[T][8 * sk + 2], h[T][8 * sk + 3], h[T][8 * sk + 4], h[T][8 * sk + 5], h[T][8 * sk + 6], h[T][8 * sk + 7]);
                        y = MFMA32(Ac[T][sk], xb, y); }
                u32x2 o0, o1; o0.x = pk2c(gelu_t(y[0]), gelu_t(y[1])); o0.y = pk2c(gelu_t(y[2]), gelu_t(y[3])); o1.x = pk2c(gelu_t(y[4]), gelu_t(y[5])); o1.y = pk2c(gelu_t(y[6]), gelu_t(y[7]));
                bf16_t* zo = zu + (size_t)step * DIN + 4 * hf;
                *(u32x2*)zo = o0; *(u32x2*)(zo + 8) = o1;
            }
            u = un;
        }
        if (!PASS_B) {
#pragma unroll
            for (int T = 0; T < 4; ++T)
#pragma unroll
                for (int i = 0; i < 16; ++i) S5S[s5_idx(g, T, crow(i, hf), s)] = h[T][i];
        }
    }
}
__device__ __forceinline__ void s5_carry(const float2* __restrict__ lamtab, const float* S5S, float* S5H, int idx) {
    const int b = idx / (NG * NP), gp = idx % (NG * NP), g = gp / NP, p = gp % NP;
    float2 L = lamtab[gp];
#pragma unroll
    for (int k = 0; k < 5; ++k) { const float nr = L.x * L.x - L.y * L.y, ni = 2.f * L.x * L.y; L.x = nr; L.y = ni; }
    static_assert(S5_L == 32, "lambda^L by 5 squarings");
    const size_t ore = ((size_t)(g * 128 + p)) * S5_NS + (size_t)b * S5_NC, oim = ore + (size_t)64 * S5_NS;
    const f32x4* sre = (const f32x4*)(S5S + ore); const f32x4* sim = (const f32x4*)(S5S + oim);
    f32x4* hre = (f32x4*)(S5H + ore); f32x4* him = (f32x4*)(S5H + oim);
    float Hr = 0.f, Hi = 0.f;
#pragma unroll 4
    for (int c4 = 0; c4 < S5_NC / 4; ++c4) {
        const f32x4 vr = sre[c4], vi = sim[c4]; f32x4 orr, oi;
#pragma unroll
        for (int j = 0; j < 4; ++j) { orr[j] = Hr; oi[j] = Hi; const float nr = L.x * Hr - L.y * Hi + vr[j], ni = L.x * Hi + L.y * Hr + vi[j]; Hr = nr; Hi = ni; }
        hre[c4] = orr; him[c4] = oi;
    }
}
}

namespace cg = cooperative_groups;
#define LAS __attribute__((address_space(3)))
constexpr int NWAVES = 8, NTHREADS = NWAVES * 64;
constexpr int LDS_BYTES = 147456;
typedef float f32x4 __attribute__((ext_vector_type(4)));
typedef unsigned u32x4 __attribute__((ext_vector_type(4)));
typedef unsigned u32x2 __attribute__((ext_vector_type(2)));
struct Args { const float* in[N_IN]; float* out; unsigned char* ws; int ph_lo, ph_hi; };
static_assert(sizeof(Args) == (N_IN + 2) * 8 + 8, "Args has no padding");

__device__ __forceinline__ unsigned pk2(float lo, float hi) { return pg8::cvt_pk_bf16(lo, hi); }
__device__ __forceinline__ int rowmap(int mode, int n) { return mode == 0 ? n : ((n >> 7) * 256 + (mode == 2 ? 128 : 0) + (n & 127)); }
struct TItem { const float* W; bf16_t* WT; int K, N, mode, item; };
__device__ __forceinline__ void titem_load(const TItem& t, float (&v)[32], int lane) {
    const int nblk = t.N / 32, kb = t.item / nblk, nb = t.item % nblk;
    const float* p = t.W + (size_t)(64 * kb + (lane >> 5)) * t.N + 32 * nb + (lane & 31);
#pragma unroll
    for (int i = 0; i < 32; ++i) v[i] = p[(size_t)(2 * i) * t.N];
}
__device__ __forceinline__ void titem_finish(const TItem& t, const float (&v)[32], LAS float* scr, int lane) {
    const int nblk = t.N / 32, kb = t.item / nblk, nb = t.item % nblk, k0 = 64 * kb, n0 = 32 * nb;
#pragma unroll
    for (int i = 0; i < 32; ++i) scr[(2 * i + (lane >> 5)) * 33 + (lane & 31)] = v[i];
    asm volatile("s_waitcnt lgkmcnt(0)" ::: "memory");
    const int c = lane & 7, rbase = rowmap(t.mode, n0);
#pragma unroll
    for (int j = 0; j < 4; ++j) { const int n = (lane >> 3) + 8 * j; const LAS float* s = scr + (8 * c) * 33 + n;
        u32x4 o; o.x = pk2(s[0 * 33], s[1 * 33]); o.y = pk2(s[2 * 33], s[3 * 33]); o.z = pk2(s[4 * 33], s[5 * 33]); o.w = pk2(s[6 * 33], s[7 * 33]);
        *(u32x4*)(t.WT + (size_t)(rbase + n) * t.K + k0 + 8 * c) = o; }
    asm volatile("s_waitcnt lgkmcnt(0)" ::: "memory");
}
#define TRANSPOSE_RUN(MK, lo_, hi_, widx_, nw_, scr_, lane_) do { int it_ = (lo_) + (widx_); \
        if (it_ < (hi_)) { float va_[32], vb_[32]; TItem ca_ = MK(it_), cb_ = ca_; titem_load(ca_, va_, lane_); \
            for (;;) { \
                const bool hb_ = it_ + (nw_) < (hi_); if (hb_) { cb_ = MK(it_ + (nw_)); titem_load(cb_, vb_, lane_); } \
                titem_finish(ca_, va_, scr_, lane_); if (!hb_) break; it_ += (nw_); \
                const bool ha_ = it_ + (nw_) < (hi_); if (ha_) { ca_ = MK(it_ + (nw_)); titem_load(ca_, va_, lane_); } \
                titem_finish(cb_, vb_, scr_, lane_); if (!ha_) break; it_ += (nw_); } } } while (0)
__device__ __forceinline__ float wave_sum(float v) {
#pragma unroll
    for (int o = 1; o < 64; o <<= 1) v += __shfl_xor(v, o);
    return v;
}
__device__ __forceinline__ void ln_row(float* xrow, const float* __restrict__ g, const float* __restrict__ bt, bf16_t* orow, int lane) {
    f32x4* xr = (f32x4*)xrow + lane;
    f32x4 v[8]; float s = 0.f;
#pragma unroll
    for (int j = 0; j < 8; ++j) { v[j] = xr[64 * j]; s += (v[j].x + v[j].y) + (v[j].z + v[j].w); }
    const float mean = wave_sum(s) * (1.f / D); float s2 = 0.f;
#pragma unroll
    for (int j = 0; j < 8; ++j) { v[j] = v[j] - mean; s2 += (v[j].x * v[j].x + v[j].y * v[j].y) + (v[j].z * v[j].z + v[j].w * v[j].w); }
    const float rstd = rsqrtf(wave_sum(s2) * (1.f / D) + LN_EPS);
#pragma unroll
    for (int j = 0; j < 8; ++j) { const f32x4 gv = *((const f32x4*)g + lane + 64 * j), bv = *((const f32x4*)bt + lane + 64 * j);
        const f32x4 y = v[j] * rstd * gv + bv; xr[64 * j] = y;
        if (orow) { u32x2 w; w.x = pk2(y.x, y.y); w.y = pk2(y.z, y.w); *((u32x2*)orow + lane + 64 * j) = w; } }
}


#define XB_TMO      128
#define XB_XCNT(j)  (256  + 64 * (j))
#define XB_XSUB(j)  (1280 + 64 * (j))
#define XB_XGEN(j)  (2304 + 64 * (j))
#define XB_TOP      3328
#define XB_TOPGEN   3392
#define XCD_BAR_WORDS 3456
#define XB_SPIN_CAP (1u << 18)
__device__ __forceinline__ unsigned xb_ld(unsigned* p)              { return __hip_atomic_load(p, __ATOMIC_RELAXED, __HIP_MEMORY_SCOPE_AGENT); }
__device__ __forceinline__ unsigned xb_add(unsigned* p, unsigned v) { return __hip_atomic_fetch_add(p, v, __ATOMIC_RELAXED, __HIP_MEMORY_SCOPE_AGENT); }
__device__ __forceinline__ unsigned xb_xcc_id() { return (unsigned)__builtin_amdgcn_s_getreg((3 << 11) | 20) & 0xFu; }
#define XB_SPIN(cond, bar) do { unsigned _sp = 0; while (cond) { __builtin_amdgcn_s_sleep(1); \
    if ((++_sp & 255u) == 0u) { if (xb_ld(&(bar)[XB_TMO])) break; if (_sp > XB_SPIN_CAP) { atomicAdd(&(bar)[XB_TMO], 1u); break; } } } } while (0)
struct XcdBarrier { unsigned* bar; unsigned x; volatile LAS unsigned* st; };
__device__ __forceinline__ XcdBarrier xcd_barrier_post(unsigned* bar, volatile LAS unsigned* st, int wave_s) {
    XcdBarrier b; b.bar = bar; b.x = xb_xcc_id(); b.st = st;
    if (fresh_tid(wave_s) == 0) (void)xb_add(&bar[XB_XCNT(b.x)], 1u);
    return b;
}
__device__ __forceinline__ void xcd_barrier_complete(unsigned* bar, unsigned x, unsigned& nloc, unsigned& nx) {
    const unsigned G = gridDim.x * gridDim.y * gridDim.z;
    unsigned sum, cnt, mine, sp = 0u;
    for (;;) {
        sum = 0u; cnt = 0u; mine = 0u;
#pragma unroll
        for (unsigned j = 0; j < 16; ++j) { const unsigned c = xb_ld(&bar[XB_XCNT(j)]); sum += c; cnt += (c > 0u) ? 1u : 0u; mine = (j == x) ? c : mine; }
        if (sum == G) break;
        __builtin_amdgcn_s_sleep(1);
        if ((++sp & 255u) == 0u) { if (xb_ld(&bar[XB_TMO])) break; if (sp > XB_SPIN_CAP) { atomicAdd(&bar[XB_TMO], 1u); break; } }
    }
    nloc = mine > 0u ? mine : 1u; nx = cnt > 0u ? cnt : 1u;
}
__device__ __forceinline__ void xcd_barrier(const XcdBarrier& b, int wave_s) {
    asm volatile("s_waitcnt vmcnt(0)" ::: "memory");
    __syncthreads();
    if (fresh_tid(wave_s) == 0) {
        unsigned* bar = b.bar;
        __builtin_amdgcn_s_waitcnt(0);
        unsigned nloc = b.st[0], nx = b.st[1];
        if (nloc == 0u) { xcd_barrier_complete(bar, b.x, nloc, nx); b.st[0] = nloc; b.st[1] = nx; }
        const unsigned old = xb_add(&bar[XB_XSUB(b.x)], 1u);
        const unsigned gen = old / nloc;
        if (old + 1u == (gen + 1u) * nloc) {
            __builtin_amdgcn_fence(__ATOMIC_RELEASE, "agent");
            asm volatile("s_waitcnt vmcnt(0)" ::: "memory");
            const unsigned og = xb_add(&bar[XB_TOP], 1u);
            const unsigned tg = og / nx;
            if (og + 1u == (tg + 1u) * nx) xb_add(&bar[XB_TOPGEN], 1u);
            else XB_SPIN(xb_ld(&bar[XB_TOPGEN]) == tg, bar);
            __builtin_amdgcn_fence(__ATOMIC_ACQUIRE, "agent");
            xb_add(&bar[XB_XGEN(b.x)], 1u);
            asm volatile("s_waitcnt vmcnt(0)" ::: "memory");
        } else {
            XB_SPIN(xb_ld(&bar[XB_XGEN(b.x)]) == gen, bar);
            __builtin_amdgcn_fence(__ATOMIC_ACQUIRE, "agent");
            asm volatile("s_waitcnt vmcnt(0)" ::: "memory");
        }
    }
    __syncthreads();
}

__global__ void __launch_bounds__(NTHREADS, 2) mk_fwd(Args a) {
    extern __shared__ __attribute__((aligned(16))) unsigned char lds_raw[];
    LAS unsigned char* lds = (LAS unsigned char*)lds_raw;
    cg::grid_group grid = cg::this_grid();
    const int wave_s = __builtin_amdgcn_readfirstlane(threadIdx.x >> 6);
#define FRESH_IDS() const int tid = fresh_tid(wave_s), lane = tid & 63, wave = wave_s, gw = bx * NWAVES + wave; (void)lane; (void)gw
    const int G = gridDim.x, bx = blockIdx.x;
    const int NGW = G * NWAVES;
    unsigned char* ws = a.ws;
    bf16_t *Wt_in = (bf16_t*)(ws + WS_WIN), *Wt_a = (bf16_t*)(ws + WS_WA), *Wt_glu = (bf16_t*)(ws + WS_WGLU), *Wt_out = (bf16_t*)(ws + WS_WOUT), *Wt_up = (bf16_t*)(ws + WS_WUP), *Wt_down = (bf16_t*)(ws + WS_WDOWN);
    bf16_t *X1B = (bf16_t*)(ws + WS_X1B), *Z = (bf16_t*)(ws + WS_Z), *HMID = (bf16_t*)(ws + WS_Z), *XB = (bf16_t*)a.out;
    const int lo = a.ph_lo, hi = a.ph_hi;
#ifndef MK_DUP
#define MK_DUP 0
#endif
#define DUP(k) (((MK_DUP >> (k)) & 1) != 0)
#define IN(k) (lo <= (k) && (k) < hi)
    volatile LAS unsigned* MISC = (volatile LAS unsigned*)(lds + LDS_BYTES - 64);
    { const int t0 = fresh_tid(wave_s); if (t0 < 16) MISC[t0] = 0u; }
    __syncthreads();
    XcdBarrier xbar = xcd_barrier_post((unsigned*)(ws + WS_CTL), MISC, wave_s);
#ifndef MK_CG_SEAMS
#define MK_CG_SEAMS 0
#endif
#define SEAM(k) do { if (IN(k) && IN((k) + 1)) { if ((k) < MK_CG_SEAMS) grid.sync(); else xcd_barrier(xbar, wave_s); } } while (0)

    constexpr int L_A = (D / 64) * (D / 32), L_GL = (DSSM / 64) * (D / 32), L_UP = (D / 64) * (DFF / 32), L_DN = (DFF / 64) * (D / 32), L_TOTAL = 2 * L_A + 2 * L_GL + L_UP + L_DN;
    constexpr int L_CUT1 = 8192, L_CUT2 = 16384;
    auto mk_late = [&](int it) -> TItem { int r = it;
        if (r < L_A) return TItem{a.in[I_WAOUT], Wt_a, D, D, 0, r}; r -= L_A;
        if (r < L_GL) return TItem{a.in[I_GLUW], Wt_glu, DSSM, D, 1, r}; r -= L_GL;
        if (r < L_GL) return TItem{a.in[I_GLUV], Wt_glu, DSSM, D, 2, r}; r -= L_GL;
        if (r < L_A) return TItem{a.in[I_WOUT], Wt_out, D, D, 0, r}; r -= L_A;
        if (r < L_UP) return TItem{a.in[I_WUP], Wt_up, D, DFF, 0, r}; r -= L_UP;
        return TItem{a.in[I_WDOWN], Wt_down, DFF, D, 0, r}; };
    auto mk_in = [&](int it) -> TItem { return TItem{a.in[I_WIN], Wt_in, D, DIN, 0, it}; };
#define LATE_ITEMS(lo_, hi_, widx_, nw_) TRANSPOSE_RUN(mk_late, lo_, hi_, widx_, nw_, (LAS float*)(lds + 73728 + wave * 8448), lane)
    for (int rep0 = 0; rep0 < (DUP(0) ? 2 : 1); ++rep0) if (IN(0)) {
        FRESH_IDS();
        LAS float* scr = (LAS float*)(lds + wave * 16384);
        constexpr int I_IN = (D / 64) * (DIN / 32);
        TRANSPOSE_RUN(mk_in, 0, I_IN, gw, NGW, scr, lane);
        {
            const float* x = a.in[I_X]; const size_t n8 = (size_t)M * D / 8;
            for (size_t i = (size_t)bx * NTHREADS + tid; i < n8; i += (size_t)G * NTHREADS) {
                const f32x4 v0 = *((const f32x4*)x + 2 * i), v1 = *((const f32x4*)x + 2 * i + 1);
                u32x4 w; w.x = pk2(v0.x, v0.y); w.y = pk2(v0.z, v0.w); w.z = pk2(v1.x, v1.y); w.w = pk2(v1.z, v1.w);
                *((u32x4*)XB + i) = w; }
        }
        for (int idx = bx * NTHREADS + tid; idx < 16 * 4 * 2 * 8 * 64; idx += G * NTHREADS) scan::rglru_pack_weights(a.in[I_WA], a.in[I_WX], (bf16_t*)(ws + WS_RGW), idx);
        {
            const int idx = bx * NTHREADS + tid;
            if (idx < NG * NP) {
                float2* lam = (float2*)(ws + WS_S5LAM); float* bbr = (float*)(ws + WS_S5BBR); float* bbi = (float*)(ws + WS_S5BBI);
                const int g = idx / NP;
                const double dt = exp((double)a.in[I_LOGDT][g]);
                const double lr = fmin((double)a.in[I_ARE][idx], -1e-4), li = (double)a.in[I_AIM][idx];
                const double mag = exp(lr * dt), lbr = mag * cos(li * dt), lbi = mag * sin(li * dt);
                const double zr = lbr - 1.0, zi = lbi, den = lr * lr + li * li;
                const double fr = (zr * lr + zi * li) / den, fi = (zi * lr - zr * li) / den;
                lam[idx] = make_float2((float)lbr, (float)lbi);
                for (int h = 0; h < GS; ++h) { const double br = a.in[I_BRE][idx * GS + h], bi = a.in[I_BIM][idx * GS + h];
                    bbr[idx * GS + h] = (float)(fr * br - fi * bi); bbi[idx * GS + h] = (float)(fr * bi + fi * br); }
            }
        }
        __syncthreads();
    }
    SEAM(0);
    if (IN(1)) { pg8::Gemm g{XB, D, Wt_in, D, M, DIN, D}; pg8::StaticOrder S; S.init(M, DIN, G, bx); pg8::gemm_phase(lds, g, S, pg8::EpiZ{Z}, wave_s); if (DUP(1)) pg8::gemm_phase(lds, g, S, pg8::EpiZ{Z}, wave_s); }
    SEAM(1);
    {
        const float2* lamtab = (const float2*)(ws + WS_S5LAM); const float* bbr = (const float*)(ws + WS_S5BBR); const float* bbi = (const float*)(ws + WS_S5BBI);
        const bf16_t* RGW = (const bf16_t*)(ws + WS_RGW); float *RGP = (float*)(ws + scan::WS_RGP), *RGS = (float*)(ws + scan::WS_RGS), *RGH = (float*)(ws + scan::WS_RGH), *S5S = (float*)(ws + scan::WS_S5S), *S5H = (float*)(ws + scan::WS_S5H);
        if (IN(2)) {
            FRESH_IDS();
            scan::rglru_pass<false>(lds, Z, a.in[I_CONVW], a.in[I_CONVB], RGW, a.in[I_BA], a.in[I_BX], a.in[I_LAM], RGP, RGS, RGH, bx, G, wave_s);
            scan::s5_pass<false>(Z, lamtab, bbr, bbi, a.in[I_CRE], a.in[I_CIM], a.in[I_SD], S5S, S5H, (LAS scan::f32x2v*)(lds + 2 * scan::RG_HB_LDS + wave * 512), gw, NGW, lane);
            if (gw >= scan::S5_UNITS) LATE_ITEMS(0, L_CUT1, gw - scan::S5_UNITS, NGW - scan::S5_UNITS);
            if (DUP(2)) { __syncthreads(); scan::rglru_pass<false>(lds, Z, a.in[I_CONVW], a.in[I_CONVB], RGW, a.in[I_BA], a.in[I_BX], a.in[I_LAM], RGP, RGS, RGH, bx, G, wave_s); }
            if (DUP(12)) { scan::s5_pass<false>(Z, lamtab, bbr, bbi, a.in[I_CRE], a.in[I_CIM], a.in[I_SD], S5S, S5H, (LAS scan::f32x2v*)(lds + 2 * scan::RG_HB_LDS + wave * 512), gw, NGW, lane); }
        }
        SEAM(2);
        if (IN(3)) {
            FRESH_IDS();
            if (tid < 48) for (int idx = bx * 48 + tid; idx < NB * NG * NP + NB * D; idx += G * 48) {
                if (idx < NB * NG * NP) scan::s5_carry(lamtab, S5S, S5H, idx); else scan::rglru_carry(RGP, RGS, RGH, idx - NB * NG * NP); }
            if (wave >= 1) LATE_ITEMS(L_CUT1, L_CUT2, bx * (NWAVES - 1) + wave - 1, G * (NWAVES - 1));
            if (DUP(3)) { if (tid < 48) for (int idx = bx * 48 + tid; idx < NB * NG * NP + NB * D; idx += G * 48) {
                if (idx < NB * NG * NP) scan::s5_carry(lamtab, S5S, S5H, idx); else scan::rglru_carry(RGP, RGS, RGH, idx - NB * NG * NP); } }
        }
        SEAM(3);
        if (IN(4)) {
            FRESH_IDS();
            if (DUP(4)) scan::rglru_pass<true, true>(lds, Z, a.in[I_CONVW], a.in[I_CONVB], RGW, a.in[I_BA], a.in[I_BX], a.in[I_LAM], RGP, RGS, RGH, bx, G, wave_s, (bf16_t*)a.out);
            scan::rglru_pass<true>(lds, Z, a.in[I_CONVW], a.in[I_CONVB], RGW, a.in[I_BA], a.in[I_BX], a.in[I_LAM], RGP, RGS, RGH, bx, G, wave_s);
            scan::s5_pass<true>(Z, lamtab, bbr, bbi, a.in[I_CRE], a.in[I_CIM], a.in[I_SD], S5S, S5H, (LAS scan::f32x2v*)(lds + 2 * scan::RG_HB_LDS + wave * 512), gw, NGW, lane);
            if (gw >= scan::S5_UNITS) LATE_ITEMS(L_CUT2, L_TOTAL, gw - scan::S5_UNITS, NGW - scan::S5_UNITS);
        }
        SEAM(4);
    }
    if (IN(5)) { pg8::Gemm g{Z + O_U, DIN, Wt_glu, DSSM, M, 2 * D, DSSM}; pg8::StaticOrder S; S.init(M, 2 * D, G, bx); pg8::gemm_phase(lds, g, S, pg8::EpiGlu{Z}, wave_s); }
    SEAM(5);
    if (IN(6)) { pg8::Gemm g{Z + O_GR, DIN, Wt_a, D, M, D, D}; pg8::StaticOrder S; S.init(M, D, G, bx); pg8::gemm_phase(lds, g, S, pg8::EpiMix{Z}, wave_s); }
    SEAM(6);
    if (IN(7)) { pg8::Gemm g{Z + O_GA, DIN, Wt_out, D, M, D, D}; pg8::StaticOrder S; S.init(M, D, G, bx); pg8::gemm_phase(lds, g, S, pg8::EpiR1{a.in[I_X], a.out}, wave_s); if (DUP(7)) pg8::gemm_phase(lds, g, S, pg8::EpiR1{a.in[I_X], a.out}, wave_s); }
    SEAM(7);
    if (IN(8)) { FRESH_IDS(); for (int m = gw; m < M; m += NGW) ln_row(a.out + (size_t)m * D, a.in[I_LN1G], a.in[I_LN1B], X1B + (size_t)m * D, lane); }
    SEAM(8);
    if (IN(9)) { pg8::Gemm g{X1B, D, Wt_up, D, M, DFF, D}; pg8::StaticOrder S; S.init(M, DFF, G, bx); pg8::gemm_phase(lds, g, S, pg8::EpiUp{HMID, a.in[I_BUP]}, wave_s); if (DUP(9)) pg8::gemm_phase(lds, g, S, pg8::EpiUp{HMID, a.in[I_BUP]}, wave_s); }
    SEAM(9);
    if (IN(10)) { pg8::Gemm g{HMID, DFF, Wt_down, DFF, M, D, DFF}; pg8::StaticOrder S; S.init(M, D, G, bx); pg8::gemm_phase(lds, g, S, pg8::EpiR2{a.out, a.in[I_BDOWN]}, wave_s); }
    SEAM(10);
    if (IN(11)) { FRESH_IDS(); for (int m = gw; m < M; m += NGW) ln_row(a.out + (size_t)m * D, a.in[I_LN2G], a.in[I_LN2B], nullptr, lane); }
#undef IN
#undef SEAM
}

#ifndef MK_SCAN_NAIVE
#define MK_SCAN_NAIVE 0
#endif
static hipError_t launch_mk(Args& a, int lo, int hi, int grid, hipStream_t stream) {
    a.ph_lo = lo; a.ph_hi = hi; void* args[] = {&a};
    return hipLaunchCooperativeKernel((const void*)mk_fwd, dim3(grid), dim3(NTHREADS), args, LDS_BYTES, stream);
}
extern "C" void kernel_launch(void* const* d_in, const int* in_sizes, int n_in, void* d_out, int out_size, void* d_ws, size_t ws_size, hipStream_t stream) {
    static int grid = 0;
    if (grid == 0) {
        if (n_in != N_IN || out_size != M * D || ws_size < WS_END) { fprintf(stderr, "kernel_launch: unexpected shapes (n_in %d out %d ws %zu)\n", n_in, out_size, ws_size); grid = -1; return; }
        int dev = 0, cus = 0, per_cu = 0;
        if (hipGetDevice(&dev) != hipSuccess || hipDeviceGetAttribute(&cus, hipDeviceAttributeMultiprocessorCount, dev) != hipSuccess) { grid = -1; return; }
        if (hipFuncSetAttribute((const void*)mk_fwd, hipFuncAttributeMaxDynamicSharedMemorySize, LDS_BYTES) != hipSuccess) { fprintf(stderr, "kernel_launch: hipFuncSetAttribute failed\n"); grid = -1; return; }
        if (hipOccupancyMaxActiveBlocksPerMultiprocessor(&per_cu, (const void*)mk_fwd, NTHREADS, LDS_BYTES) != hipSuccess || per_cu < 1) { fprintf(stderr, "kernel_launch: occupancy query says %d\n", per_cu); grid = -1; return; }
        grid = cus;
#if MK_SCAN_NAIVE
        (void)hipFuncSetAttribute((const void*)nv::k_rglru, hipFuncAttributeMaxDynamicSharedMemorySize, (2 * HD * HD + HD) * 4);
#endif
    }
    if (grid < 0) return;
    Args a{};
    for (int i = 0; i < N_IN; ++i) a.in[i] = (const float*)d_in[i];
    a.out = (float*)d_out; a.ws = (unsigned char*)d_ws;
    hipError_t e;
    if (hipMemsetAsync((char*)d_ws + WS_CTL, 0, 16384, stream) != hipSuccess) { fprintf(stderr, "kernel_launch: memset of the barrier words failed\n"); return; }
#if MK_SCAN_NAIVE
    unsigned char* ws = (unsigned char*)d_ws; bf16_t* Z = (bf16_t*)(ws + WS_Z);
    e = launch_mk(a, 0, 2, grid, stream);
    nv::k_rglru<<<NB * HEADS, 128, (2 * HD * HD + HD) * 4, stream>>>(Z, a.in[I_CONVW], a.in[I_CONVB], a.in[I_WA], a.in[I_BA], a.in[I_WX], a.in[I_BX], a.in[I_LAM]);
    nv::k_s5<<<NB * NG, 64, 0, stream>>>(Z, (const float2*)(ws + WS_S5LAM), (const float*)(ws + WS_S5BBR), (const float*)(ws + WS_S5BBI), a.in[I_CRE], a.in[I_CIM], a.in[I_SD]);
    if (e == hipSuccess) e = launch_mk(a, 5, 12, grid, stream);
#else
    e = launch_mk(a, 0, 12, grid, stream);
#endif
    if (e != hipSuccess) fprintf(stderr, "kernel_launch: cooperative launch failed: %s (grid %d)\n", hipGetErrorString(e), grid);
}
```
